# Optimizing an MI355X kernel written in HIP

```python
import math
import jax, jax.numpy as jnp
from jax import lax
import numpy as np

D_MODEL = 1024
BATCH = 4
SEQ = 4096
DEPTH = 1

N_ATTN_HEADS = 8
ATTN_HEAD_DIM = 64
ATTN_WIDTH = N_ATTN_HEADS * ATTN_HEAD_DIM
MOBA_BLOCK = 256
MOBA_TOPK = 3
MOBA_QCHUNK = 64
ROPE_THETA = 10000.0
N_MLSTM_HEADS = 4
MLSTM_HEAD_DIM = 128
MLSTM_WIDTH = N_MLSTM_HEADS * MLSTM_HEAD_DIM
MLSTM_CHUNK = 64
MLSTM_CONV = 4
D_FF = 2816
FFN_CONV = 3
D_IN = 3 * ATTN_WIDTH + 4 * MLSTM_WIDTH + 2 * N_MLSTM_HEADS + 2 * D_MODEL
EPS = 1e-6
NEG = -1e30

kernel_name = "hybrid_moba_mlstm_convglu_block"


def rms_norm(x, g):
    xf = x.astype(jnp.float32)
    y = xf * lax.rsqrt(jnp.mean(xf * xf, axis=-1, keepdims=True) + EPS)
    return (y * g.astype(jnp.float32)).astype(x.dtype)


def causal_dwconv(x, w):
    width = w.shape[0]
    s = x.shape[1]
    xp = jnp.pad(x, ((0, 0), (width - 1, 0), (0, 0)))
    out = w[0] * xp[:, 0:s]
    for j in range(1, width):
        out = out + w[j] * xp[:, j:j + s]
    return out


def split_heads(t, n_heads, head_dim):
    b, s, _ = t.shape
    return t.reshape(b, s, n_heads, head_dim).transpose(0, 2, 1, 3)


def merge_heads(t):
    b, h, s, d = t.shape
    return t.transpose(0, 2, 1, 3).reshape(b, s, h * d)


def rope(t, positions):
    half = t.shape[-1] // 2
    inv_freq = ROPE_THETA ** (-(jnp.arange(half, dtype=jnp.float32) / half))
    ang = positions.astype(jnp.float32)[:, None, :, None] * inv_freq
    cos, sin = jnp.cos(ang), jnp.sin(ang)
    t1 = t[..., :half].astype(jnp.float32)
    t2 = t[..., half:].astype(jnp.float32)
    return jnp.concatenate([t1 * cos - t2 * sin, t2 * cos + t1 * sin], axis=-1).astype(t.dtype)


def moba_attention(q, k, v):
    b, h, s, d = q.shape
    nb = -(-s // MOBA_BLOCK)
    pad = nb * MOBA_BLOCK - s
    kp = jnp.pad(k, ((0, 0), (0, 0), (0, pad), (0, 0))).reshape(b, h, nb, MOBA_BLOCK, d)
    vp = jnp.pad(v, ((0, 0), (0, 0), (0, pad), (0, 0))).reshape(b, h, nb, MOBA_BLOCK, d)
    k_mean = jnp.mean(kp.astype(jnp.float32), axis=3).astype(k.dtype)
    topk = min(MOBA_TOPK, nb)
    scale = 1.0 / math.sqrt(d)
    n_chunks = s // MOBA_QCHUNK
    bi = jnp.arange(b)[:, None, None, None]
    hi = jnp.arange(h)[None, :, None, None]
    blk_ids = jnp.arange(nb)

    def chunk_fn(c):
        start = c * MOBA_QCHUNK
        qc = lax.dynamic_slice_in_dim(q, start, MOBA_QCHUNK, axis=2)
        j = start // MOBA_BLOCK
        gate = jnp.einsum('bhqd,bhnd->bhqn', qc, k_mean, preferred_element_type=jnp.float32)
        gate = jnp.where(blk_ids < j, gate, NEG)
        _, idx = lax.top_k(gate, topk)
        valid = idx < j
        kg = kp[bi, hi, idx]
        vg = vp[bi, hi, idx]
        s_sel = jnp.einsum('bhqd,bhqtnd->bhqtn', qc, kg, preferred_element_type=jnp.float32) * scale
        s_sel = jnp.where(valid[..., None], s_sel, NEG).reshape(b, h, MOBA_QCHUNK, topk * MOBA_BLOCK)
        k_own = lax.dynamic_index_in_dim(kp, j, axis=2, keepdims=False)
        v_own = lax.dynamic_index_in_dim(vp, j, axis=2, keepdims=False)
        s_own = jnp.einsum('bhqd,bhkd->bhqk', qc, k_own, preferred_element_type=jnp.float32) * scale
        q_pos = start + jnp.arange(MOBA_QCHUNK)
        k_pos = j * MOBA_BLOCK + jnp.arange(MOBA_BLOCK)
        s_own = jnp.where(k_pos[None, :] <= q_pos[:, None], s_own, NEG)
        p = jax.nn.softmax(jnp.concatenate([s_sel, s_own], axis=-1), axis=-1)
        p_sel = p[..., :topk * MOBA_BLOCK].reshape(b, h, MOBA_QCHUNK, topk, MOBA_BLOCK).astype(v.dtype)
        p_own = p[..., topk * MOBA_BLOCK:].astype(v.dtype)
        return (jnp.einsum('bhqtn,bhqtnd->bhqd', p_sel, vg)
                + jnp.einsum('bhqk,bhkd->bhqd', p_own, v_own))

    out = lax.map(chunk_fn, jnp.arange(n_chunks))
    return out.transpose(1, 2, 0, 3, 4).reshape(b, h, s, d)


def mlstm_chunkwise(q, k, v, i_pre, f_pre):
    dtype = v.dtype
    b, h, s, dk = q.shape
    dv = v.shape[-1]
    nc = s // MLSTM_CHUNK
    L = MLSTM_CHUNK
    qf = q.astype(jnp.float32)
    kf = k.astype(jnp.float32) / math.sqrt(dk)
    vf = v.astype(jnp.float32)
    log_f = jax.nn.log_sigmoid(f_pre.astype(jnp.float32))
    log_i = i_pre.astype(jnp.float32)

    def chunks(t):
        t = t.reshape((b, h, nc, L) + t.shape[3:])
        return jnp.moveaxis(t, 2, 0)

    b_cum = jnp.cumsum(log_f.reshape(b, h, nc, L), axis=-1)
    xs = (chunks(qf), chunks(kf), chunks(vf), chunks(log_i), jnp.moveaxis(b_cum, 2, 0))
    tril = jnp.tril(jnp.ones((L, L), dtype=bool))

    def step(carry, inp):
        C, n, m = carry
        qc, kc, vc, ac, bc = inp
        dmat = jnp.where(tril, bc[..., :, None] - bc[..., None, :] + ac[..., None, :], NEG)
        inter = bc + m[..., None]
        m_t = jnp.maximum(inter, jnp.max(dmat, axis=-1))
        w_intra = jnp.exp(dmat - m_t[..., None])
        w_inter = jnp.exp(inter - m_t)
        scores = w_intra * jnp.einsum('bhld,bhsd->bhls', qc, kc)
        num = (w_inter[..., None] * jnp.einsum('bhld,bhdv->bhlv', qc, C)
               + jnp.einsum('bhls,bhsv->bhlv', scores, vc))
        den = w_inter * jnp.einsum('bhld,bhd->bhl', qc, n) + jnp.sum(scores, axis=-1)
        h_out = num / jnp.maximum(jnp.abs(den), jnp.exp(-m_t))[..., None]
        b_last = bc[..., -1]
        dec = b_last[..., None] - bc + ac
        m_new = jnp.maximum(b_last + m, jnp.max(dec, axis=-1))
        wk = jnp.exp(dec - m_new[..., None])
        carry_scale = jnp.exp(b_last + m - m_new)
        C_new = carry_scale[..., None, None] * C + jnp.einsum('bhs,bhsd,bhsv->bhdv', wk, kc, vc)
        n_new = carry_scale[..., None] * n + jnp.einsum('bhs,bhsd->bhd', wk, kc)
        return (C_new, n_new, m_new), h_out

    init = (jnp.zeros((b, h, dk, dv), jnp.float32), jnp.zeros((b, h, dk), jnp.float32),
            jnp.zeros((b, h), jnp.float32))
    _, hs = lax.scan(step, init, xs)
    return jnp.moveaxis(hs, 0, 2).reshape(b, h, s, dv).astype(dtype)


def setup_inputs(seed: int = 0) -> dict:
    key = jax.random.key(seed)
    ks = jax.random.split(key, 16)

    def nrm(k, shape, scale):
        return jax.random.normal(k, shape, jnp.float32) * scale

    x = nrm(ks[0], (BATCH, SEQ, D_MODEL), 1.0)
    positions = jnp.broadcast_to(jnp.arange(SEQ, dtype=jnp.int32), (BATCH, SEQ))
    return {
        "x": x,
        "positions": positions,
        "norm_mix_g": 1.0 + nrm(ks[1], (DEPTH, D_MODEL), 0.02),
        "w_in": nrm(ks[2], (DEPTH, D_MODEL, D_IN), D_MODEL ** -0.5),
        "conv_mlstm": nrm(ks[3], (DEPTH, MLSTM_CONV, 2 * MLSTM_WIDTH), MLSTM_CONV ** -0.5),
        "i_bias": nrm(ks[4], (DEPTH, N_MLSTM_HEADS), 0.1),
        "f_bias": 3.0 + nrm(ks[5], (DEPTH, N_MLSTM_HEADS), 0.5),
        "mlstm_norm_g": 1.0 + nrm(ks[6], (DEPTH, MLSTM_WIDTH), 0.02),
        "w_branch_attn": nrm(ks[7], (DEPTH, ATTN_WIDTH, D_MODEL), ATTN_WIDTH ** -0.5),
        "w_branch_mlstm": nrm(ks[8], (DEPTH, MLSTM_WIDTH, D_MODEL), MLSTM_WIDTH ** -0.5),
        "w_out": nrm(ks[9], (DEPTH, D_MODEL, D_MODEL), D_MODEL ** -0.5),
        "norm_ffn_g": 1.0 + nrm(ks[10], (DEPTH, D_MODEL), 0.02),
        "w_up": nrm(ks[11], (DEPTH, D_MODEL, 2 * D_FF), D_MODEL ** -0.5),
        "conv_ffn": nrm(ks[12], (DEPTH, FFN_CONV, 2 * D_FF), FFN_CONV ** -0.5),
        "w_down": nrm(ks[13], (DEPTH, D_FF, D_MODEL), D_FF ** -0.5),
        "norm_final_g": 1.0 + nrm(ks[14], (D_MODEL,), 0.02),
    }


def reference(x, positions, norm_mix_g, w_in, conv_mlstm, i_bias, f_bias, mlstm_norm_g,
              w_branch_attn, w_branch_mlstm, w_out, norm_ffn_g, w_up, conv_ffn, w_down,
              norm_final_g):
    sizes = [ATTN_WIDTH] * 3 + [MLSTM_WIDTH] * 4 + [N_MLSTM_HEADS] * 2 + [D_MODEL] * 2
    split_points = [int(p) for p in np.cumsum(sizes)[:-1]]
    for layer in range(DEPTH):
        h = rms_norm(x, norm_mix_g[layer])
        proj = h @ w_in[layer]
        (q_a, k_a, v_a, q_m, k_m, v_m, o_m, i_m, f_m, g_a, g_m) = jnp.split(proj, split_points, axis=-1)

        qa = rope(split_heads(q_a, N_ATTN_HEADS, ATTN_HEAD_DIM), positions)
        ka = rope(split_heads(k_a, N_ATTN_HEADS, ATTN_HEAD_DIM), positions)
        va = split_heads(v_a, N_ATTN_HEADS, ATTN_HEAD_DIM)
        y_attn = merge_heads(moba_attention(qa, ka, va)) @ w_branch_attn[layer]

        qk_m = jax.nn.silu(causal_dwconv(jnp.concatenate([q_m, k_m], axis=-1), conv_mlstm[layer]))
        qm, km = jnp.split(qk_m, 2, axis=-1)
        i_pre = (i_m + i_bias[layer]).transpose(0, 2, 1)
        f_pre = (f_m + f_bias[layer]).transpose(0, 2, 1)
        hm = mlstm_chunkwise(split_heads(qm, N_MLSTM_HEADS, MLSTM_HEAD_DIM),
                             split_heads(km, N_MLSTM_HEADS, MLSTM_HEAD_DIM),
                             split_heads(v_m, N_MLSTM_HEADS, MLSTM_HEAD_DIM), i_pre, f_pre)
        hm = rms_norm(hm, mlstm_norm_g[layer].reshape(N_MLSTM_HEADS, 1, MLSTM_HEAD_DIM))
        y_mlstm = (merge_heads(hm) * jax.nn.sigmoid(o_m)) @ w_branch_mlstm[layer]

        merged = jax.nn.sigmoid(g_a) * y_attn + jax.nn.sigmoid(g_m) * y_mlstm
        x = x + merged @ w_out[layer]

        h2 = rms_norm(x, norm_ffn_g[layer])
        u = causal_dwconv(h2 @ w_up[layer], conv_ffn[layer])
        gate, up = jnp.split(u, 2, axis=-1)
        x = x + (jax.nn.silu(gate) * up) @ w_down[layer]
    return rms_norm(x, norm_final_g)
```

```cpp
#include <hip/hip_runtime.h>
#include <hip/hip_cooperative_groups.h>
#include <cstdio>
#include <cstdint>
namespace cg = cooperative_groups;
namespace pg8 {
#define PG8_LAS __attribute__((address_space(3)))
typedef unsigned short bf16_t;
typedef short bf16x8 __attribute__((ext_vector_type(8)));
typedef float f32x4 __attribute__((ext_vector_type(4)));
typedef unsigned u32x4 __attribute__((ext_vector_type(4)));
constexpr int BM = 256, BK = 64, HALF = 128, HTB = HALF * BK * 2  , STAGE_BYTES = 8 * HTB, NXCD = 8, WGM = 8;

__host__ __device__ __forceinline__ int lds_byte(int r, int c) { const int st = (r >> 4) * 2 + (c >> 5), rr = r & 15, cc = c & 31, ob = rr * 64 + cc * 2; return st * 1024 + (ob ^ (((ob >> 9) & 1) << 5)); }
__host__ __device__ __forceinline__ void stage_rc(int b, int& R, int& C) { const int st = b / 1024, sb = b % 1024, swz = sb ^ (((sb >> 9) & 1) << 5); R = (st >> 1) * 16 + swz / 64; C = (st & 1) * 32 + (swz % 64) / 2; }
__host__ __device__ __forceinline__ int perm32(int rho) { const int n = rho >> 4, i = rho & 15; return 8 * (i >> 2) + 4 * n + (i & 3); }

struct Unit { int pm, pn; };
struct Gemm { const bf16_t* A; const bf16_t* Bt; int M, N, K, lda, ldb; };

struct StaticOrder {
    int nM, nN, nwg, G, c;
    __host__ __device__ void init(int M, int N, int G_, int c_) { nM = M / BM; nN = N / BM; nwg = nM * nN; G = G_; c = c_; }
    __host__ __device__ bool next(int i, Unit& u) const {
        const long L = (long)i * G + c; if (L >= nwg) return false;
        int wgid = (int)L; { const int q = nwg / NXCD, r = nwg % NXCD, xcd = wgid % NXCD, off = wgid / NXCD; wgid = (xcd < r ? xcd * (q + 1) : r * (q + 1) + (xcd - r) * q) + off; }
        const int nig = WGM * nN, gid = wgid / nig, fm = gid * WGM, gsz = (nM - fm) < WGM ? (nM - fm) : WGM;
        u.pm = fm + ((wgid % nig) % gsz); u.pn = (wgid % nig) / gsz; return true;
    }
    __device__ __forceinline__ void a_ready(const Unit&) const {}
    __device__ __forceinline__ void done(const Unit&) const {}
};

__device__ __forceinline__ unsigned cvt_pk_bf16(float lo, float hi) { unsigned r; asm volatile("v_cvt_pk_bf16_f32 %0, %1, %2" : "=v"(r) : "v"(lo), "v"(hi)); return r; }
template <class Epi, class Sched, bool ALIGN_EPI = false, bool SP2 = false>
__device__ __forceinline__ void gemm_phase(PG8_LAS unsigned char* lds, const Gemm g, const Sched& S, const Epi& E) {
    const int tid = threadIdx.x, wid = __builtin_amdgcn_readfirstlane(tid >> 6), lane = tid & 63, wr = wid >> 2, wc = wid & 3, fr = lane & 15, fq = lane >> 4;
    const int K = g.K, nt = K / BK;
    unsigned voffA[2], voffB[2];
#pragma unroll
    for (int i = 0; i < 2; ++i) { int R, C; stage_rc(tid * 16 + i * 8192, R, C); const int Rb = Epi::PERM ? ((R & ~31) + perm32(R & 31)) : R;
        voffA[i] = (unsigned)(R * g.lda + C) * 2u; voffB[i] = (unsigned)(Rb * g.ldb + C) * 2u; }
    const size_t kstep = (size_t)(BK * 2);
    const size_t hstepA = (size_t)HALF * g.lda * 2, hstepB = (size_t)HALF * g.ldb * 2;
    const size_t tstepA = 2 * hstepA, tstepB = 2 * hstepB;
    const unsigned ldsw = (unsigned)wid * 1024u;
    const int aoff = lds_byte(wr * 64 + fr, fq * 8), boff = lds_byte(wc * 32 + fr, fq * 8);
#define PG8_SA(b, h) (((b) * 2 + (h)) * HTB)
#define PG8_SB(b, h) ((4 + (b) * 2 + (h)) * HTB)
#define PG8_STAGE(bufoff, gbase, voff) do { _Pragma("unroll") for (int _i = 0; _i < 2; ++_i) \
        __builtin_amdgcn_global_load_lds((const unsigned*)((const char*)(gbase) + (voff)[_i]), (PG8_LAS unsigned*)(lds + (bufoff) + ldsw + _i * 8192), 16, 0, 0); } while (0)
#define PG8_LDA(dst, b, h) do { _Pragma("unroll") for (int m = 0; m < 4; ++m) _Pragma("unroll") for (int k = 0; k < 2; ++k) dst[m][k] = *(const PG8_LAS bf16x8*)(lds + PG8_SA(b, h) + aoff + m * 2048 + k * 1024); } while (0)
#define PG8_LDB(dst, b, h) do { _Pragma("unroll") for (int n = 0; n < 2; ++n) _Pragma("unroll") for (int k = 0; k < 2; ++k) dst[n][k] = *(const PG8_LAS bf16x8*)(lds + PG8_SB(b, h) + boff + n * 2048 + k * 1024); } while (0)
#define PG8_MMA(ai, bj, At, Bt) do { __builtin_amdgcn_s_setprio(1); _Pragma("unroll") for (int m = 0; m < 4; ++m) _Pragma("unroll") for (int n = 0; n < 2; ++n) _Pragma("unroll") for (int k = 0; k < 2; ++k) \
        acc[ai][bj][m][n] = __builtin_amdgcn_mfma_f32_16x16x32_bf16(Bt[n][k], At[m][k], acc[ai][bj][m][n], 0, 0, 0); __builtin_amdgcn_s_setprio(0); } while (0)
#define PG8_WAIT_V(n) asm volatile("s_waitcnt vmcnt(" #n ")" ::: "memory")
#define PG8_WAIT_L(n) asm volatile("s_waitcnt lgkmcnt(" #n ")" ::: "memory")
#define PG8_BAR __builtin_amdgcn_s_barrier()
#define PG8_SCHED __builtin_amdgcn_sched_barrier(0)
    Unit cur, nxt; int ui = 0;
    if (!S.next(0, cur)) return;
    f32x4 acc[2][2][4][2];
#pragma unroll
    for (int a = 0; a < 2; ++a)
#pragma unroll
        for (int b = 0; b < 2; ++b)
#pragma unroll
            for (int m = 0; m < 4; ++m)
#pragma unroll
                for (int n = 0; n < 2; ++n) acc[a][b][m][n] = (f32x4){0.f, 0.f, 0.f, 0.f};
    bf16x8 At[4][2], B0[2][2], B1[2][2];
    const char* cA = (const char*)g.A + (size_t)cur.pm * tstepA; const char* cB = (const char*)g.Bt + (size_t)cur.pn * tstepB;
    S.a_ready(cur);
    if constexpr (SP2) {
        PG8_STAGE(PG8_SB(0, 0), cB, voffB); PG8_STAGE(PG8_SB(0, 1), cB + hstepB, voffB); PG8_STAGE(PG8_SA(0, 0), cA, voffA); PG8_STAGE(PG8_SA(0, 1), cA + hstepA, voffA);
        if (wr == 1) PG8_BAR;
        PG8_WAIT_V(2); PG8_BAR;
        PG8_STAGE(PG8_SB(1, 0), cB + kstep, voffB); PG8_STAGE(PG8_SA(1, 0), cA + kstep, voffA); PG8_STAGE(PG8_SB(1, 1), cB + hstepB + kstep, voffB);
        PG8_WAIT_V(6); PG8_BAR;
    } else {
        PG8_STAGE(PG8_SB(0, 0), cB, voffB); PG8_STAGE(PG8_SA(0, 0), cA, voffA); PG8_STAGE(PG8_SB(0, 1), cB + hstepB, voffB); PG8_STAGE(PG8_SA(0, 1), cA + hstepA, voffA);
        if (wr == 1) PG8_BAR;
        PG8_WAIT_V(4); PG8_BAR;
        PG8_STAGE(PG8_SB(1, 0), cB + kstep, voffB); PG8_STAGE(PG8_SA(1, 0), cA + kstep, voffA); PG8_STAGE(PG8_SB(1, 1), cB + hstepB + kstep, voffB);
        PG8_WAIT_V(6); PG8_BAR;
    }
    for (;;) {
        const bool has_next = S.next(ui + 1, nxt);
        const char* nA = has_next ? (const char*)g.A + (size_t)nxt.pm * tstepA : cA; const char* nB = has_next ? (const char*)g.Bt + (size_t)nxt.pn * tstepB : cB;
        for (int t = 0; t < nt; t += 2) {
            const bool last = (t == nt - 2);
            const char* a1 = cA + (size_t)(t + 1) * kstep;
            const char* a2 = last ? nA : cA + (size_t)(t + 2) * kstep; const char* b2 = last ? nB : cB + (size_t)(t + 2) * kstep;
            const char* a3 = a2 + kstep; const char* b3 = b2 + kstep;
            if (last && has_next) S.a_ready(nxt);
            if constexpr (SP2) {
            PG8_LDB(B0, 0, 0); PG8_LDB(B1, 0, 1); PG8_SCHED; PG8_LDA(At, 0, 0); PG8_STAGE(PG8_SA(1, 1), a1 + hstepA, voffA);
            PG8_WAIT_V(8); PG8_WAIT_L(0); PG8_BAR; PG8_MMA(0, 0, At, B0); PG8_MMA(0, 1, At, B1); PG8_BAR; PG8_SCHED;
            PG8_LDA(At, 0, 1); PG8_STAGE(PG8_SB(0, 0), b2, voffB); PG8_STAGE(PG8_SB(0, 1), b2 + hstepB, voffB); PG8_STAGE(PG8_SA(0, 0), a2, voffA);
            PG8_WAIT_V(8); PG8_WAIT_L(0); PG8_BAR; PG8_MMA(1, 0, At, B0); PG8_MMA(1, 1, At, B1); PG8_BAR; PG8_SCHED;
            PG8_LDB(B0, 1, 0); PG8_LDB(B1, 1, 1); PG8_SCHED; PG8_LDA(At, 1, 0); PG8_STAGE(PG8_SA(0, 1), a2 + hstepA, voffA);
            PG8_WAIT_V(8); PG8_WAIT_L(0); PG8_BAR; PG8_MMA(0, 0, At, B0); PG8_MMA(0, 1, At, B1); PG8_BAR; PG8_SCHED;
            PG8_LDA(At, 1, 1); PG8_STAGE(PG8_SB(1, 0), b3, voffB); PG8_STAGE(PG8_SB(1, 1), b3 + hstepB, voffB); PG8_STAGE(PG8_SA(1, 0), a3, voffA);
            PG8_WAIT_V(8); PG8_WAIT_L(0); PG8_BAR; PG8_MMA(1, 0, At, B0); PG8_MMA(1, 1, At, B1); PG8_BAR; PG8_SCHED;
            } else {
            PG8_LDB(B0, 0, 0); PG8_SCHED; PG8_LDA(At, 0, 0); PG8_STAGE(PG8_SA(1, 1), a1 + hstepA, voffA);
            PG8_WAIT_L(8); PG8_BAR; PG8_WAIT_L(0); PG8_MMA(0, 0, At, B0); PG8_BAR; PG8_SCHED;
            PG8_LDB(B1, 0, 1); PG8_STAGE(PG8_SB(0, 0), b2, voffB);
            PG8_BAR; PG8_WAIT_L(0); PG8_MMA(0, 1, At, B1); PG8_BAR;
            PG8_LDA(At, 0, 1); PG8_STAGE(PG8_SA(0, 0), a2, voffA);
            PG8_BAR; PG8_WAIT_L(0); PG8_MMA(1, 0, At, B0); PG8_BAR; PG8_SCHED;
            PG8_STAGE(PG8_SB(0, 1), b2 + hstepB, voffB);
            PG8_WAIT_V(6); PG8_BAR; PG8_MMA(1, 1, At, B1); PG8_BAR;
            PG8_LDB(B0, 1, 0); PG8_SCHED; PG8_LDA(At, 1, 0); PG8_STAGE(PG8_SA(0, 1), a2 + hstepA, voffA);
            PG8_WAIT_L(8); PG8_BAR; PG8_WAIT_L(0); PG8_MMA(0, 0, At, B0); PG8_BAR; PG8_SCHED;
            PG8_LDB(B1, 1, 1); PG8_STAGE(PG8_SB(1, 0), b3, voffB);
            PG8_BAR; PG8_WAIT_L(0); PG8_MMA(0, 1, At, B1); PG8_BAR;
            PG8_LDA(At, 1, 1); PG8_STAGE(PG8_SA(1, 0), a3, voffA);
            PG8_BAR; PG8_WAIT_L(0); PG8_MMA(1, 0, At, B0); PG8_BAR; PG8_SCHED;
            PG8_STAGE(PG8_SB(1, 1), b3 + hstepB, voffB);
            PG8_WAIT_V(6); PG8_BAR; PG8_MMA(1, 1, At, B1); PG8_BAR;
            }
        }
        if constexpr (ALIGN_EPI) { if (wr == 0) PG8_BAR; }
        if constexpr (!Epi::AFTER_DRAIN) { E(acc, cur, wr, wc, fr, fq); S.done(cur); }
        if (!has_next) break;
#pragma unroll
        for (int a = 0; a < 2; ++a)
#pragma unroll
            for (int b = 0; b < 2; ++b)
#pragma unroll
                for (int m = 0; m < 4; ++m)
#pragma unroll
                    for (int n = 0; n < 2; ++n) acc[a][b][m][n] = (f32x4){0.f, 0.f, 0.f, 0.f};
        cur = nxt; cA = nA; cB = nB; ++ui;
        if constexpr (ALIGN_EPI) { if (wr == 1) PG8_BAR; }
    }
    PG8_WAIT_V(0);
    if constexpr (!ALIGN_EPI) { if (wr == 0) PG8_BAR; }
    PG8_BAR;
    if constexpr (Epi::AFTER_DRAIN) { E.fused(acc, cur, wr, wc, fr, fq, lds, wid, lane); S.done(cur); }
#undef PG8_SA
#undef PG8_SB
#undef PG8_STAGE
#undef PG8_LDA
#undef PG8_LDB
#undef PG8_MMA
#undef PG8_WAIT_V
#undef PG8_WAIT_L
#undef PG8_BAR
#undef PG8_SCHED
}
}

#define LAS __attribute__((address_space(3)))
typedef unsigned short bf16;
typedef short bf16x8 __attribute__((ext_vector_type(8)));
typedef float f32x4 __attribute__((ext_vector_type(4)));
typedef float f32x16 __attribute__((ext_vector_type(16)));
typedef unsigned u32x4 __attribute__((ext_vector_type(4)));
typedef unsigned u32x2 __attribute__((ext_vector_type(2)));
constexpr int NB = 4, SEQ = 4096, DM = 1024, MT = NB * SEQ;
constexpr int NPROJ = 5640, NPROJ_PAD = 5888, DFF = 2816, NUP = 5632;
constexpr int C_QA = 0, C_KA = 512, C_VA = 1024, C_QM = 1536, C_KM = 2048, C_VM = 2560, C_OM = 3072, C_GA = 3584, C_GM = 4608, C_I = 5632, C_F = 5636;
constexpr float EPS = 1e-6f;
constexpr float QSCALE = 0.125f * 1.4426950408889634f;
constexpr float NEGF = -1e30f;
constexpr size_t MiB = 1u << 20;
constexpr size_t WS_RSS1 = 0, WS_RSS2 = 64 * 1024, WS_GA = 128 * 1024, WS_GB = 384 * 1024, WS_ST = 640 * 1024, WS_MC = 648 * 1024, WS_CSC = 652 * 1024,
                 WS_KSUM = 1 * MiB, WS_NL = 2 * MiB;
constexpr size_t WS_WIN = 4 * MiB, WS_WUP = WS_WIN + 23 * MiB / 2, WS_WDN = WS_WUP + 11 * MiB, WS_WO = 32 * MiB, WS_WBA = 34 * MiB, WS_WBM = 35 * MiB;
constexpr size_t WS_H = 36 * MiB;
constexpr size_t WS_QM = WS_H, WS_KM = WS_H + 16 * MiB, WS_MRG = WS_H, WS_U = WS_H;
constexpr size_t WS_PROJ = 68 * MiB;
constexpr size_t WS_G = 124 * MiB;
constexpr size_t WS_X1B = 224 * MiB;
constexpr size_t WS_END = 256 * MiB;
constexpr int LDS_BYTES = 147456;

__device__ __forceinline__ float bf2f(unsigned short v) { return __uint_as_float((unsigned)v << 16); }
__device__ __forceinline__ unsigned short f2bf(float f) { unsigned u = __float_as_uint(f); return (unsigned short)((u + 0x7fffu + ((u >> 16) & 1u)) >> 16); }
__device__ __forceinline__ unsigned pk2(float lo, float hi) { return (unsigned)f2bf(lo) | ((unsigned)f2bf(hi) << 16); }
__device__ __forceinline__ float bflo(unsigned w) { return __uint_as_float(w << 16); }
__device__ __forceinline__ float bfhi(unsigned w) { return __uint_as_float(w & 0xffff0000u); }
__device__ __forceinline__ float sigmoidf_(float v) { return 1.0f / (1.0f + __expf(-v)); }
__device__ __forceinline__ float siluf_(float v) { return v / (1.0f + __expf(-v)); }
__device__ __forceinline__ float red32_sum(float v) { v += __shfl_xor(v, 1); v += __shfl_xor(v, 2); v += __shfl_xor(v, 4); v += __shfl_xor(v, 8); v += __shfl_xor(v, 16); return v; }
__device__ __forceinline__ float wave_sum(float v) {
#pragma unroll
    for (int o = 1; o < 64; o <<= 1) v += __shfl_xor(v, o);
    return v;
}
__device__ __forceinline__ float wave_max(float v) {
#pragma unroll
    for (int o = 1; o < 64; o <<= 1) v = fmaxf(v, __shfl_xor(v, o));
    return v;
}
__device__ __forceinline__ f32x16 mma32(f32x16 acc, const LAS bf16* A, int lda, const LAS bf16* B, int ldb, int ksteps, int lane) {
    const int r = lane & 31, h = lane >> 5;
    const LAS bf16* ap = A + r * lda + 8 * h; const LAS bf16* bp = B + r * ldb + 8 * h;
    for (int ks = 0; ks < ksteps; ++ks) {
        const bf16x8 a = *(const LAS bf16x8*)(ap + 16 * ks), b = *(const LAS bf16x8*)(bp + 16 * ks);
        acc = __builtin_amdgcn_mfma_f32_32x32x16_bf16(a, b, acc, 0, 0, 0);
    }
    return acc;
}
__device__ __forceinline__ int crow(int i, int h) { return (i & 3) + 8 * (i >> 2) + 4 * h; }
using pg8::Unit; using pg8::cvt_pk_bf16;
typedef const f32x4 (&AccRef)[2][2][4][2];
__device__ __forceinline__ u32x4 pack8(f32x4 a, f32x4 b) { u32x4 w; w.x = cvt_pk_bf16(a[0], a[1]); w.y = cvt_pk_bf16(a[2], a[3]); w.z = cvt_pk_bf16(b[0], b[1]); w.w = cvt_pk_bf16(b[2], b[3]); return w; }
__device__ __forceinline__ void unpack8(u32x4 w, f32x4& a, f32x4& b) { a = (f32x4){bflo(w.x), bfhi(w.x), bflo(w.y), bfhi(w.y)}; b = (f32x4){bflo(w.z), bfhi(w.z), bflo(w.w), bfhi(w.w)}; }
__device__ __forceinline__ f32x4 sig4(f32x4 v) { return (f32x4){sigmoidf_(v[0]), sigmoidf_(v[1]), sigmoidf_(v[2]), sigmoidf_(v[3])}; }
#define EPI_LOOP_BEGIN  _Pragma("unroll") for (int ai = 0; ai < 2; ++ai) _Pragma("unroll") for (int m = 0; m < 4; ++m) { const int row = u.pm * 256 + ai * 128 + wr * 64 + m * 16 + fr;
#define EPI_COL(bj) (u.pn * 256 + (bj) * 128 + wc * 32 + 8 * fq)
struct EpiProj { static constexpr bool PERM = true, AFTER_DRAIN = false; bf16* O;
    __device__ __forceinline__ void operator()(AccRef acc, const Unit& u, int wr, int wc, int fr, int fq) const {
        EPI_LOOP_BEGIN
#pragma unroll
            for (int bj = 0; bj < 2; ++bj) { const int col = EPI_COL(bj); if (col < NPROJ) *(u32x4*)(O + (size_t)row * NPROJ + col) = pack8(acc[ai][bj][m][0], acc[ai][bj][m][1]); }
        }
    }
};
template <bool ADD> struct EpiGate { static constexpr bool PERM = true, AFTER_DRAIN = false; const bf16* P; bf16* T; int gcol0;
    __device__ __forceinline__ void operator()(AccRef acc, const Unit& u, int wr, int wc, int fr, int fq) const {
        EPI_LOOP_BEGIN
#pragma unroll
            for (int bj = 0; bj < 2; ++bj) { const int col = EPI_COL(bj);
                const u32x4 gw = *(const u32x4*)(P + (size_t)row * NPROJ + gcol0 + col); f32x4 g0, g1; unpack8(gw, g0, g1);
                f32x4 v0 = acc[ai][bj][m][0] * sig4(g0), v1 = acc[ai][bj][m][1] * sig4(g1);
                bf16* tp = T + (size_t)row * DM + col;
                if (ADD) { f32x4 t0, t1; unpack8(*(const u32x4*)tp, t0, t1); v0 += t0; v1 += t1; }
                *(u32x4*)tp = pack8(v0, v1); }
        }
    }
};
struct EpiRes1 { static constexpr bool PERM = true, AFTER_DRAIN = false; const float* x; float* x1; bf16* x1b; float* rss;
    __device__ __forceinline__ void operator()(AccRef acc, const Unit& u, int wr, int wc, int fr, int fq) const {
        EPI_LOOP_BEGIN
            float ss = 0.f;
#pragma unroll
            for (int bj = 0; bj < 2; ++bj) { const int col = EPI_COL(bj); const size_t off = (size_t)row * DM + col;
                const f32x4 v0 = acc[ai][bj][m][0] + *(const f32x4*)(x + off), v1 = acc[ai][bj][m][1] + *(const f32x4*)(x + off + 4);
                *(f32x4*)(x1 + off) = v0; *(f32x4*)(x1 + off + 4) = v1; *(u32x4*)(x1b + off) = pack8(v0, v1);
                ss += (v0[0] * v0[0] + v0[1] * v0[1]) + (v0[2] * v0[2] + v0[3] * v0[3]) + (v1[0] * v1[0] + v1[1] * v1[1]) + (v1[2] * v1[2] + v1[3] * v1[3]); }
            ss += __shfl_xor(ss, 16); ss += __shfl_xor(ss, 32);
            if (fq == 0) unsafeAtomicAdd(rss + row, ss);
        }
    }
};
struct EpiUp { static constexpr bool PERM = true, AFTER_DRAIN = false; bf16* U; const float* rss;
    __device__ __forceinline__ void operator()(AccRef acc, const Unit& u, int wr, int wc, int fr, int fq) const {
        EPI_LOOP_BEGIN
            const float rs = rsqrtf(rss[row] * (1.0f / DM) + EPS);
#pragma unroll
            for (int bj = 0; bj < 2; ++bj) { const int col = EPI_COL(bj); *(u32x4*)(U + (size_t)row * NUP + col) = pack8(acc[ai][bj][m][0] * rs, acc[ai][bj][m][1] * rs); }
        }
    }
};
struct EpiRes2 { static constexpr bool PERM = true, AFTER_DRAIN = false; float* xio; float* rss;
    __device__ __forceinline__ void operator()(AccRef acc, const Unit& u, int wr, int wc, int fr, int fq) const {
        EPI_LOOP_BEGIN
            float ss = 0.f;
#pragma unroll
            for (int bj = 0; bj < 2; ++bj) { const int col = EPI_COL(bj); const size_t off = (size_t)row * DM + col;
                const f32x4 v0 = acc[ai][bj][m][0] + *(const f32x4*)(xio + off), v1 = acc[ai][bj][m][1] + *(const f32x4*)(xio + off + 4);
                *(f32x4*)(xio + off) = v0; *(f32x4*)(xio + off + 4) = v1;
                ss += (v0[0] * v0[0] + v0[1] * v0[1]) + (v0[2] * v0[2] + v0[3] * v0[3]) + (v1[0] * v1[0] + v1[1] * v1[1]) + (v1[2] * v1[2] + v1[3] * v1[3]); }
            ss += __shfl_xor(ss, 16); ss += __shfl_xor(ss, 32);
            if (fq == 0) unsafeAtomicAdd(rss + row, ss);
        }
    }
};
template <int MODE> __device__ __forceinline__ void transpose_item(const float* W, int K, int N, bf16* WT, LAS float* scr, int item, int lane, const float* gk) {
    const int nblk = (N + 31) / 32, kb = item / nblk, nb = item % nblk, k0 = 64 * kb, n0 = 32 * nb;
#pragma unroll 8
    for (int i = 0; i < 32; ++i) { const int kk = 2 * i + (lane >> 5), n = n0 + (lane & 31);
        float v = (n < N) ? W[(size_t)(k0 + kk) * N + n] : 0.f; if (MODE == 2) v *= gk[k0 + kk]; scr[kk * 33 + (lane & 31)] = v; }
    asm volatile("s_waitcnt lgkmcnt(0)" ::: "memory");
    const int c = lane & 7;
#pragma unroll
    for (int j = 0; j < 4; ++j) { const int nl = (lane >> 3) + 8 * j, n = n0 + nl; const LAS float* s = scr + (8 * c) * 33 + nl;
        if (n < N) { int dn = n; if (MODE == 1) dn = (n < 3584) ? n : ((n < 3592) ? (C_I + (n - 3584)) : (n - 8));
            u32x4 o; o.x = pk2(s[0 * 33], s[1 * 33]); o.y = pk2(s[2 * 33], s[3 * 33]); o.z = pk2(s[4 * 33], s[5 * 33]); o.w = pk2(s[6 * 33], s[7 * 33]);
            *(u32x4*)(WT + (size_t)dn * K + k0 + 8 * c) = o; } }
    asm volatile("s_waitcnt lgkmcnt(0)" ::: "memory");
}
struct P0Args { const float *x, *g1, *w_in, *wba, *wbm, *wo, *g2, *wup, *wdn; bf16 *WinT, *WbaT, *WbmT, *WoT, *WupT, *WdnT, *H; float *rss1, *rss2; };
__device__ __forceinline__ void p0_prologue(const P0Args& a, LAS unsigned char* lds, int tid, int G) {
    const int lane = tid & 63, wave = tid >> 6;
    LAS float* scr = (LAS float*)(lds + wave * 16384);
    const int gw = blockIdx.x * 8 + wave, NGW = G * 8;
    constexpr int I_IN = (DM / 64) * ((NPROJ + 31) / 32), I_BA = (512 / 64) * (DM / 32), I_O = (DM / 64) * (DM / 32), I_UP = (DM / 64) * (NUP / 32), I_DN = (DFF / 64) * (DM / 32);
    constexpr int NITEMS = I_IN + 2 * I_BA + I_O + I_UP + I_DN;
    for (int it = gw; it < NITEMS; it += NGW) {
        int r = it;
        if (r < I_IN) { transpose_item<1>(a.w_in, DM, NPROJ, a.WinT, scr, r, lane, nullptr); continue; } r -= I_IN;
        if (r < I_BA) { transpose_item<0>(a.wba, 512, DM, a.WbaT, scr, r, lane, nullptr); continue; } r -= I_BA;
        if (r < I_BA) { transpose_item<0>(a.wbm, 512, DM, a.WbmT, scr, r, lane, nullptr); continue; } r -= I_BA;
        if (r < I_O) { transpose_item<0>(a.wo, DM, DM, a.WoT, scr, r, lane, nullptr); continue; } r -= I_O;
        if (r < I_UP) { transpose_item<2>(a.wup, DM, NUP, a.WupT, scr, r, lane, a.g2); continue; } r -= I_UP;
        transpose_item<0>(a.wdn, DFF, DM, a.WdnT, scr, r, lane, nullptr);
    }
    for (int m = gw; m < MT; m += NGW) {
        const f32x4* xr = (const f32x4*)(a.x + (size_t)m * DM) + lane; f32x4 v[4]; float s = 0.f;
#pragma unroll
        for (int j = 0; j < 4; ++j) { v[j] = xr[64 * j]; s += (v[j][0] * v[j][0] + v[j][1] * v[j][1]) + (v[j][2] * v[j][2] + v[j][3] * v[j][3]); }
        const float rstd = rsqrtf(wave_sum(s) * (1.0f / DM) + EPS);
        u32x2* o8 = (u32x2*)(a.H + (size_t)m * DM) + lane;
#pragma unroll
        for (int j = 0; j < 4; ++j) { const f32x4 g = *((const f32x4*)a.g1 + lane + 64 * j); u32x2 w; w.x = pk2(v[j][0] * rstd * g[0], v[j][1] * rstd * g[1]); w.y = pk2(v[j][2] * rstd * g[2], v[j][3] * rstd * g[3]); o8[64 * j] = w; }
    }
    for (int i = blockIdx.x * 512 + tid; i < MT; i += G * 512) { a.rss1[i] = 0.f; a.rss2[i] = 0.f; }
}

struct P2Args { bf16* P; const int* pos; const float *conv_m, *i_bias, *f_bias; bf16 *QM, *KM; float *GA, *GB, *ST, *KSUM; };
__device__ __forceinline__ void p2_unit(const P2Args& a, LAS unsigned char* lds, int tid, int cu) {
    const int lane = tid & 63, wave = tid >> 6;
    const int b = cu >> 6, c = cu & 63, t0 = b * SEQ + c * 64;
    LAS float* cs = (LAS float*)lds;
    LAS float* sn = cs + 2048;
    LAS float* ks2 = sn + 2048;
    for (int e = tid; e < 2048; e += 512) { const int tok = e >> 5, i = e & 31; const float invf = powf(10000.0f, -(float)i * (1.0f / 32.0f));
        const float ang = (float)a.pos[t0 + tok] * invf; float sv, cv; sincosf(ang, &sv, &cv); cs[e] = cv; sn[e] = sv; }
    __syncthreads();
    {
        const int isk = tid >> 8, hh = (tid & 255) >> 5, i = tid & 31; const int col = (isk ? C_KA : C_QA) + hh * 64 + i; const float sc = isk ? 1.0f : QSCALE;
        float s1 = 0.f, s2 = 0.f;
        for (int tok = 0; tok < 64; ++tok) { bf16* p = a.P + (size_t)(t0 + tok) * NPROJ + col; const float v1 = bf2f(p[0]), v2 = bf2f(p[32]);
            const float cv = cs[tok * 32 + i], sv = sn[tok * 32 + i]; const float o1 = v1 * cv - v2 * sv, o2 = v2 * cv + v1 * sv;
            p[0] = f2bf(o1 * sc); p[32] = f2bf(o2 * sc); s1 += o1; s2 += o2; }
        if (isk) { float* kd = a.KSUM + ((size_t)(b * 8 + hh) * 64 + c) * 64; kd[i] = s1; kd[i + 32] = s2; }
    }
    {
#pragma unroll
        for (int qk = 0; qk < 2; ++qk) { const int ch = qk * 512 + tid; const int col = (qk ? C_KM : C_QM) + tid;
            const float w0 = a.conv_m[ch], w1 = a.conv_m[1024 + ch], w2 = a.conv_m[2048 + ch], w3 = a.conv_m[3072 + ch];
            float x0 = 0.f, x1 = 0.f, x2 = 0.f;
            if (c > 0) { x0 = bf2f(a.P[(size_t)(t0 - 3) * NPROJ + col]); x1 = bf2f(a.P[(size_t)(t0 - 2) * NPROJ + col]); x2 = bf2f(a.P[(size_t)(t0 - 1) * NPROJ + col]); }
            bf16* dst = (qk ? a.KM : a.QM) + (size_t)t0 * 512 + tid; const float osc = qk ? 0.08838834764831845f : 1.0f;
            for (int tok = 0; tok < 64; ++tok) { const float x3 = bf2f(a.P[(size_t)(t0 + tok) * NPROJ + col]);
                const float y = w0 * x0 + w1 * x1 + w2 * x2 + w3 * x3; dst[(size_t)tok * 512] = f2bf(siluf_(y) * osc); x0 = x1; x1 = x2; x2 = x3; } }
    }
    if (wave < 4) {
        const int hh = wave; const size_t prow = (size_t)(t0 + lane) * NPROJ;
        const float av = bf2f(a.P[prow + C_I + hh]) + a.i_bias[hh]; const float fp = bf2f(a.P[prow + C_F + hh]) + a.f_bias[hh];
        const float lf = fminf(fp, 0.f) - log1pf(__expf(-fabsf(fp)));
        float bc = lf;
#pragma unroll
        for (int o = 1; o < 64; o <<= 1) { const float t = __shfl_up(bc, o); if (lane >= o) bc += t; }
        const float blast = __shfl(bc, 63); const float md = wave_max(blast - bc + av);
        const size_t gi = (size_t)(b * 4 + hh) * SEQ + c * 64 + lane; a.GA[gi] = av; a.GB[gi] = bc;
        if (lane == 0) { float* st = a.ST + ((size_t)(b * 4 + hh) * 64 + c) * 2; st[0] = blast; st[1] = md; }
    }
    __syncthreads();
}
struct P3Args { const bf16 *P, *KM; const float *GA, *GB, *ST; float *CT, *NL, *MC, *CSC; };
__device__ __forceinline__ void p3_unit(const P3Args& a, LAS unsigned char* lds, int tid, int un) {
    const int lane = tid & 63, wave = tid >> 6;
    const int bh = un >> 6, c = un & 63, b = bh >> 2, hh = bh & 3, t0 = b * SEQ + c * 64;
    LAS bf16* KT = (LAS bf16*)lds;
    LAS bf16* VT = KT + 128 * 72;
    LAS float* wk = (LAS float*)(VT + 128 * 72);
    LAS float* msc = wk + 64;
    if (wave == 0) {
        const float* st = a.ST + (size_t)bh * 128; const float bl = st[2 * lane], md = st[2 * lane + 1];
        float m = 0.f;
        for (int j = 0; j < c; ++j) m = fmaxf(__shfl(bl, j) + m, __shfl(md, j));
        const float blc = __shfl(bl, c), mdc = __shfl(md, c); const float mnew = fmaxf(blc + m, mdc);
        const size_t gi = (size_t)bh * SEQ + c * 64 + lane;
        wk[lane] = __expf(blc - a.GB[gi] + a.GA[gi] - mnew);
        if (lane == 0) { a.MC[un] = m; a.CSC[un] = __expf(blc + m - mnew); }
    }
    __syncthreads();
#pragma unroll
    for (int k = 0; k < 2; ++k) { const int q = tid + 512 * k, s = q >> 4, dc = (q & 15) * 8;
        const u32x4 kw = *(const u32x4*)(a.KM + (size_t)(t0 + s) * 512 + hh * 128 + dc);
        const u32x4 vw = *(const u32x4*)(a.P + (size_t)(t0 + s) * NPROJ + C_VM + hh * 128 + dc);
        const float w = wk[s]; f32x4 k0, k1; unpack8(kw, k0, k1);
#pragma unroll
        for (int e = 0; e < 4; ++e) { KT[(dc + e) * 72 + s] = f2bf(k0[e] * w); KT[(dc + 4 + e) * 72 + s] = f2bf(k1[e] * w); }
        const unsigned vv[4] = {vw.x, vw.y, vw.z, vw.w};
#pragma unroll
        for (int e = 0; e < 4; ++e) { VT[(dc + 2 * e) * 72 + s] = (bf16)(vv[e] & 0xffffu); VT[(dc + 2 * e + 1) * 72 + s] = (bf16)(vv[e] >> 16); } }
    __syncthreads();
    if (tid < 128) { float s = 0.f; for (int j = 0; j < 64; ++j) s += bf2f(KT[tid * 72 + j]); a.NL[(size_t)un * 128 + tid] = s; }
    {
        const int vt = wave >> 1, r = lane & 31, h = lane >> 5;
#pragma unroll
        for (int dd = 0; dd < 2; ++dd) { const int dt = 2 * (wave & 1) + dd; f32x16 acc; for (int i = 0; i < 16; ++i) acc[i] = 0.f;
            acc = mma32(acc, VT + 32 * vt * 72, 72, KT + 32 * dt * 72, 72, 4, lane);
            float* o = a.CT + (size_t)un * 16384 + 32 * dt + r;
#pragma unroll
            for (int i = 0; i < 16; ++i) o[(size_t)(32 * vt + crow(i, h)) * 128] = acc[i]; }
    }
    __syncthreads();
}
__device__ __forceinline__ void p4_scan(float* CT, float* NL, const float* CSC, int tid, int G) {
    const int gt = blockIdx.x * 512 + tid, NT = G * 512;
    for (int it = gt; it < 16 * 8192; it += NT) { const int bh = it >> 13, e2 = it & 8191;
        float* p = CT + (size_t)bh * 64 * 16384 + 2 * e2; const float* cs = CSC + bh * 64; float c0 = 0.f, c1 = 0.f;
#pragma unroll 8
        for (int c = 0; c < 64; ++c) { const float2 l = *(const float2*)(p + (size_t)c * 16384); *(float2*)(p + (size_t)c * 16384) = make_float2(c0, c1); const float s = cs[c]; c0 = s * c0 + l.x; c1 = s * c1 + l.y; } }
    for (int it = gt; it < 16 * 128; it += NT) { const int bh = it >> 7, e = it & 127; float* p = NL + (size_t)bh * 64 * 128 + e; const float* cs = CSC + bh * 64; float n0 = 0.f;
        for (int c = 0; c < 64; ++c) { const float l = p[c * 128]; p[c * 128] = n0; n0 = cs[c] * n0 + l; } }
}
struct P5Args { bf16* P; const bf16 *QM, *KM; const float *GA, *GB, *CT, *NL, *MC, *ng; };
__device__ __forceinline__ void p5_unit(const P5Args& a, LAS unsigned char* lds, int tid, int un) {
    const int lane = tid & 63, wave = tid >> 6, r = lane & 31, h = lane >> 5;
    const int bh = un >> 6, c = un & 63, b = bh >> 2, hh = bh & 3, t0 = b * SEQ + c * 64;
    LAS bf16* Qs = (LAS bf16*)lds;
    LAS bf16* Ks = Qs + 64 * 136;
    LAS bf16* VT = Ks + 64 * 136;
    LAS bf16* Et = VT + 128 * 72;
    LAS bf16* Ps = Et + 128 * 136;
    LAS float* fa = (LAS float*)(Ps + 64 * 72);
    LAS float* fb = fa + 64;
    LAS float* fmt = fb + 64;
    LAS float* fwi = fmt + 64;
    LAS float* fqn = fwi + 64;
    LAS float* frs = fqn + 64;
    LAS float* fss = frs + 128;
    LAS float* fnp = fss + 256;
    const float mc = a.MC[un];
#pragma unroll
    for (int k = 0; k < 2; ++k) { const int q = tid + 512 * k, s = q >> 4, dc = (q & 15) * 8;
        *(LAS u32x4*)(Qs + s * 136 + dc) = *(const u32x4*)(a.QM + (size_t)(t0 + s) * 512 + hh * 128 + dc);
        *(LAS u32x4*)(Ks + s * 136 + dc) = *(const u32x4*)(a.KM + (size_t)(t0 + s) * 512 + hh * 128 + dc);
        const u32x4 vw = *(const u32x4*)(a.P + (size_t)(t0 + s) * NPROJ + C_VM + hh * 128 + dc);
        const unsigned vv[4] = {vw.x, vw.y, vw.z, vw.w};
#pragma unroll
        for (int e = 0; e < 4; ++e) { VT[(dc + 2 * e) * 72 + s] = (bf16)(vv[e] & 0xffffu); VT[(dc + 2 * e + 1) * 72 + s] = (bf16)(vv[e] >> 16); } }
#pragma unroll
    for (int k = 0; k < 4; ++k) { const int q = tid + 512 * k, v = q >> 4, dc = (q & 15) * 8; const float* src = a.CT + (size_t)un * 16384 + v * 128 + dc;
        const f32x4 e0 = *(const f32x4*)src, e1 = *(const f32x4*)(src + 4); *(LAS u32x4*)(Et + v * 136 + dc) = pack8(e0, e1); }
    if (tid < 128) fnp[tid] = a.NL[(size_t)un * 128 + tid];
    if (tid < 64) { const size_t gi = (size_t)bh * SEQ + c * 64 + tid; fa[tid] = a.GA[gi]; fb[tid] = a.GB[gi]; }
    __syncthreads();
    if (tid < 64) { const int l = tid; float pm = NEGF; for (int s = 0; s <= l; ++s) pm = fmaxf(pm, fa[s] - fb[s]);
        const float bl = fb[l], mt = fmaxf(bl + mc, bl + pm); fmt[l] = mt; fwi[l] = __expf(bl + mc - mt);
        float qn = 0.f; for (int d = 0; d < 128; ++d) qn += bf2f(Qs[l * 136 + d]) * fnp[d]; fqn[l] = qn; }
    __syncthreads();
    if (wave < 4) {
        const int lt = wave & 1, st = wave >> 1; f32x16 acc; for (int i = 0; i < 16; ++i) acc[i] = 0.f;
        acc = mma32(acc, Qs + 32 * lt * 136, 136, Ks + 32 * st * 136, 136, 8, lane);
        const int s = 32 * st + r; const float as = fa[s], bs = fb[s];
#pragma unroll
        for (int i = 0; i < 16; ++i) { const int l = 32 * lt + crow(i, h);
            float sc = 0.f; if (s <= l) sc = __expf(fb[l] - bs + as - fmt[l]) * acc[i];
            const bf16 sb = f2bf(sc); Ps[l * 72 + s] = sb; const float rsum = red32_sum(bf2f(sb)); if (r == 0) frs[st * 64 + l] = rsum; }
    }
    __syncthreads();
    {
        const int lt = wave & 1, vt = wave >> 1; f32x16 ae, as_; for (int i = 0; i < 16; ++i) { ae[i] = 0.f; as_[i] = 0.f; }
        ae = mma32(ae, Qs + 32 * lt * 136, 136, Et + 32 * vt * 136, 136, 8, lane);
        as_ = mma32(as_, Ps + 32 * lt * 72, 72, VT + 32 * vt * 72, 72, 4, lane);
        float hv[16];
#pragma unroll
        for (int i = 0; i < 16; ++i) { const int l = 32 * lt + crow(i, h); const float wi = fwi[l]; const float den = wi * fqn[l] + frs[l] + frs[64 + l];
            const float dn = fmaxf(fabsf(den), __expf(-fmt[l])); hv[i] = (wi * ae[i] + as_[i]) / dn;
            const float sq = red32_sum(hv[i] * hv[i]); if (r == 0) fss[vt * 64 + l] = sq; }
        __syncthreads();
        const int v = 32 * vt + r; const float gv = a.ng[hh * 128 + v];
#pragma unroll
        for (int i = 0; i < 16; ++i) { const int l = 32 * lt + crow(i, h); const float ss = fss[l] + fss[64 + l] + fss[128 + l] + fss[192 + l];
            const float rstd = rsqrtf(ss * (1.0f / 128.0f) + EPS); const size_t prow = (size_t)(t0 + l) * NPROJ;
            const float om = bf2f(a.P[prow + C_OM + hh * 128 + v]); a.P[prow + C_QM + hh * 128 + v] = f2bf(hv[i] * rstd * gv * sigmoidf_(om)); }
    }
    __syncthreads();
}
struct AtArgs { bf16* P; const float* KSUM; };
__device__ __forceinline__ void attn_unit(const AtArgs& a, LAS unsigned char* lds, int tid, int bh, int j) {
    const int lane = tid & 63, wave = tid >> 6, r = lane & 31, h = lane >> 5;
    const int b = bh >> 3, hh = bh & 7, q0 = b * SEQ + j * 256;
    LAS float* kmean = (LAS float*)lds;
    LAS unsigned* qmask = (LAS unsigned*)(kmean + 1024);
    LAS unsigned* anym = qmask + 256;
    LAS bf16* Kb = (LAS bf16*)(anym + 8);
    LAS bf16* Vb = Kb + 2 * 64 * 72;
    LAS bf16* Pw = Vb + 2 * 64 * 72 + wave * 32 * 72;
    for (int e = tid; e < 1024; e += 512) { const int n = e >> 6, d = e & 63; const float* ks = a.KSUM + ((size_t)bh * 64 + n * 4) * 64 + d; kmean[e] = (ks[0] + ks[64] + ks[128] + ks[192]) * (1.0f / 256.0f); }
    __syncthreads();
    if (tid < 256) {
        unsigned msk = 0u;
        if (j > 0) {
            float qv[64]; const bf16* qp = a.P + (size_t)(q0 + tid) * NPROJ + C_QA + hh * 64;
#pragma unroll
            for (int k = 0; k < 8; ++k) { const u32x4 w = *(const u32x4*)(qp + 8 * k); f32x4 x0, x1; unpack8(w, x0, x1);
#pragma unroll
                for (int e = 0; e < 4; ++e) { qv[8 * k + e] = x0[e]; qv[8 * k + 4 + e] = x1[e]; } }
            float v0 = -3e38f, v1 = -3e38f, v2 = -3e38f; int i0 = -1, i1 = -1, i2 = -1;
            for (int n = 0; n < j; ++n) { float g = 0.f;
#pragma unroll
                for (int d = 0; d < 64; ++d) g += qv[d] * kmean[n * 64 + d];
                if (g > v0) { v2 = v1; i2 = i1; v1 = v0; i1 = i0; v0 = g; i0 = n; } else if (g > v1) { v2 = v1; i2 = i1; v1 = g; i1 = n; } else if (g > v2) { v2 = g; i2 = n; } }
            if (i0 >= 0) msk |= 1u << i0; if (i1 >= 0) msk |= 1u << i1; if (i2 >= 0) msk |= 1u << i2;
        }
        qmask[tid] = msk;
        unsigned om = msk;
#pragma unroll
        for (int o = 1; o < 64; o <<= 1) om |= __shfl_xor(om, o);
        if (lane == 0) anym[wave] = om;
    }
    __syncthreads();
    const unsigned blkmask = (anym[0] | anym[1] | anym[2] | anym[3]) | (1u << j);
    const unsigned mymask = qmask[32 * wave + r];
    bf16x8 bq[4];
    { const bf16* qp = a.P + (size_t)(q0 + 32 * wave + r) * NPROJ + C_QA + hh * 64 + 8 * h;
#pragma unroll
      for (int ks = 0; ks < 4; ++ks) bq[ks] = *(const bf16x8*)(qp + 16 * ks); }
    f32x16 o0, o1; for (int i = 0; i < 16; ++i) { o0[i] = 0.f; o1[i] = 0.f; }
    float mrun = NEGF, lrun = 0.f;
    const int srow = tid >> 3, sch = (tid & 7) * 8;
    const bf16* kbase = a.P + (size_t)(b * SEQ) * NPROJ + C_KA + hh * 64 + sch;
    const bf16* vbase = a.P + (size_t)(b * SEQ) * NPROJ + C_VA + hh * 64 + sch;
    unsigned rem = blkmask; int n = __builtin_ctz(rem), t = 0; rem &= rem - 1;
    u32x4 kreg = *(const u32x4*)(kbase + (size_t)(n * 256 + t * 64 + srow) * NPROJ), vreg = *(const u32x4*)(vbase + (size_t)(n * 256 + t * 64 + srow) * NPROJ);
    int buf = 0;
    for (;;) {
        LAS bf16* Kc = Kb + buf * 64 * 72; LAS bf16* Vc = Vb + buf * 64 * 72;
        *(LAS u32x4*)(Kc + srow * 72 + sch) = kreg;
        { const unsigned vv[4] = {vreg.x, vreg.y, vreg.z, vreg.w};
#pragma unroll
          for (int e = 0; e < 4; ++e) { Vc[(sch + 2 * e) * 72 + srow] = (bf16)(vv[e] & 0xffffu); Vc[(sch + 2 * e + 1) * 72 + srow] = (bf16)(vv[e] >> 16); } }
        __syncthreads();
        const int cn = n, ct = t;
        bool more = true; if (t < 3) ++t; else if (rem) { n = __builtin_ctz(rem); rem &= rem - 1; t = 0; } else more = false;
        if (more) { kreg = *(const u32x4*)(kbase + (size_t)(n * 256 + t * 64 + srow) * NPROJ); vreg = *(const u32x4*)(vbase + (size_t)(n * 256 + t * 64 + srow) * NPROJ); }
        const bool own = (cn == j);
        const bool active = own ? (2 * ct <= wave) : true;
        if (active) {
            f32x16 s0, s1; for (int i = 0; i < 16; ++i) { s0[i] = 0.f; s1[i] = 0.f; }
            { const LAS bf16* kp0 = Kc + r * 72 + 8 * h; const LAS bf16* kp1 = kp0 + 32 * 72;
#pragma unroll
              for (int ks = 0; ks < 4; ++ks) { s0 = __builtin_amdgcn_mfma_f32_32x32x16_bf16(*(const LAS bf16x8*)(kp0 + 16 * ks), bq[ks], s0, 0, 0, 0);
                                               s1 = __builtin_amdgcn_mfma_f32_32x32x16_bf16(*(const LAS bf16x8*)(kp1 + 16 * ks), bq[ks], s1, 0, 0, 0); } }
            const bool sel = own ? true : (((mymask >> cn) & 1u) != 0u);
            if (own) { const int qrel = 32 * wave + r - 64 * ct;
#pragma unroll
                for (int i = 0; i < 16; ++i) { const int kk = crow(i, h); if (kk > qrel) s0[i] = NEGF; if (kk + 32 > qrel) s1[i] = NEGF; } }
            float tm = NEGF;
#pragma unroll
            for (int i = 0; i < 16; ++i) tm = fmaxf(tm, fmaxf(s0[i], s1[i]));
            tm = fmaxf(tm, __shfl_xor(tm, 32));
            const float mnew = sel ? fmaxf(mrun, tm) : mrun;
            const float alpha = exp2f(mrun - mnew);
            float ps = 0.f;
#pragma unroll
            for (int i = 0; i < 16; ++i) { const float p0 = sel ? exp2f(s0[i] - mnew) : 0.f, p1 = sel ? exp2f(s1[i] - mnew) : 0.f; s0[i] = p0; s1[i] = p1; ps += p0 + p1; }
            lrun = lrun * alpha + ps; mrun = mnew;
#pragma unroll
            for (int i = 0; i < 16; ++i) { o0[i] *= alpha; o1[i] *= alpha; }
#pragma unroll
            for (int g = 0; g < 4; ++g) { u32x2 w0, w1; w0.x = cvt_pk_bf16(s0[4 * g], s0[4 * g + 1]); w0.y = cvt_pk_bf16(s0[4 * g + 2], s0[4 * g + 3]); w1.x = cvt_pk_bf16(s1[4 * g], s1[4 * g + 1]); w1.y = cvt_pk_bf16(s1[4 * g + 2], s1[4 * g + 3]);
                *(LAS u32x2*)(Pw + r * 72 + 8 * g + 4 * h) = w0; *(LAS u32x2*)(Pw + r * 72 + 32 + 8 * g + 4 * h) = w1; }
            asm volatile("s_waitcnt lgkmcnt(0)" ::: "memory");
            o0 = mma32(o0, Vc, 72, Pw, 72, 4, lane);
            o1 = mma32(o1, Vc + 32 * 72, 72, Pw, 72, 4, lane);
        }
        if (!more) break;
        buf ^= 1;
    }
    lrun += __shfl_xor(lrun, 32);
    const float inv = 1.0f / lrun;
    __syncthreads();
    bf16* op = a.P + (size_t)(q0 + 32 * wave + r) * NPROJ + C_QA + hh * 64;
#pragma unroll
    for (int g = 0; g < 4; ++g) { u32x2 w0, w1; w0.x = cvt_pk_bf16(o0[4 * g] * inv, o0[4 * g + 1] * inv); w0.y = cvt_pk_bf16(o0[4 * g + 2] * inv, o0[4 * g + 3] * inv);
        w1.x = cvt_pk_bf16(o1[4 * g] * inv, o1[4 * g + 1] * inv); w1.y = cvt_pk_bf16(o1[4 * g + 2] * inv, o1[4 * g + 3] * inv);
        *(u32x2*)(op + 8 * g + 4 * h) = w0; *(u32x2*)(op + 32 + 8 * g + 4 * h) = w1; }
    __syncthreads();
}
__device__ __forceinline__ void p9_conv(const bf16* U, bf16* Gh, const float* cw, int tid, int G) {
    const int gt = blockIdx.x * 512 + tid, NT = G * 512;
    for (int it = gt; it < 256 * 352; it += NT) { const int ch = it / 352, cg8 = (it % 352) * 8; const int r0 = ch * 32; const bool first = (r0 & (SEQ - 1)) == 0;
        f32x4 wg[3][2], wu[3][2];
#pragma unroll
        for (int k = 0; k < 3; ++k) { wg[k][0] = *(const f32x4*)(cw + k * NUP + cg8); wg[k][1] = *(const f32x4*)(cw + k * NUP + cg8 + 4); wu[k][0] = *(const f32x4*)(cw + k * NUP + DFF + cg8); wu[k][1] = *(const f32x4*)(cw + k * NUP + DFF + cg8 + 4); }
        f32x4 g0[2], g1[2], u0[2], u1[2];
        if (first) { for (int e = 0; e < 2; ++e) { g0[e] = (f32x4){0.f, 0.f, 0.f, 0.f}; g1[e] = g0[e]; u0[e] = g0[e]; u1[e] = g0[e]; } }
        else { unpack8(*(const u32x4*)(U + (size_t)(r0 - 2) * NUP + cg8), g0[0], g0[1]); unpack8(*(const u32x4*)(U + (size_t)(r0 - 1) * NUP + cg8), g1[0], g1[1]);
               unpack8(*(const u32x4*)(U + (size_t)(r0 - 2) * NUP + DFF + cg8), u0[0], u0[1]); unpack8(*(const u32x4*)(U + (size_t)(r0 - 1) * NUP + DFF + cg8), u1[0], u1[1]); }
#pragma unroll 4
        for (int t = 0; t < 32; ++t) { f32x4 g2[2], u2[2]; unpack8(*(const u32x4*)(U + (size_t)(r0 + t) * NUP + cg8), g2[0], g2[1]); unpack8(*(const u32x4*)(U + (size_t)(r0 + t) * NUP + DFF + cg8), u2[0], u2[1]);
            f32x4 o[2];
#pragma unroll
            for (int e = 0; e < 2; ++e) { const f32x4 gg = wg[0][e] * g0[e] + wg[1][e] * g1[e] + wg[2][e] * g2[e]; const f32x4 uu = wu[0][e] * u0[e] + wu[1][e] * u1[e] + wu[2][e] * u2[e];
                o[e] = (f32x4){siluf_(gg[0]) * uu[0], siluf_(gg[1]) * uu[1], siluf_(gg[2]) * uu[2], siluf_(gg[3]) * uu[3]}; g0[e] = g1[e]; g1[e] = g2[e]; u0[e] = u1[e]; u1[e] = u2[e]; }
            *(u32x4*)(Gh + (size_t)(r0 + t) * DFF + cg8) = pack8(o[0], o[1]); }
    }
}
__device__ __forceinline__ void p11_final(float* out, const float* rss2, const float* gf, int tid, int G) {
    const int lane = tid & 63, wave = tid >> 6; const int gw = blockIdx.x * 8 + wave, NGW = G * 8;
    for (int m = gw; m < MT; m += NGW) { const float rstd = rsqrtf(rss2[m] * (1.0f / DM) + EPS); f32x4* xr = (f32x4*)(out + (size_t)m * DM) + lane;
#pragma unroll
        for (int jj = 0; jj < 4; ++jj) { const f32x4 g = *((const f32x4*)gf + lane + 64 * jj); xr[64 * jj] = xr[64 * jj] * rstd * g; } }
}

struct Args { const float* in[16]; float* out; unsigned char* ws; };
#define GSYNC() grid.sync()
__device__ __forceinline__ unsigned long long karg(int i) { const volatile unsigned long long* ka = (const volatile unsigned long long*)__builtin_amdgcn_kernarg_segment_ptr(); const unsigned long long v = ka[i]; const unsigned lo = __builtin_amdgcn_readfirstlane((unsigned)v), hi = __builtin_amdgcn_readfirstlane((unsigned)(v >> 32)); return ((unsigned long long)hi << 32) | lo; }
#define KIN(i) ((const float*)karg(i))
#define KOUT() ((float*)karg(16))
#define KWS(off) ((unsigned char*)karg(17) + (off))
__global__ void __launch_bounds__(512) fwd_mega(Args args) {
    extern __shared__ __attribute__((aligned(16))) unsigned char lds_raw[];
    cg::grid_group grid = cg::this_grid();
    LAS unsigned char* lds = (LAS unsigned char*)lds_raw;
    const int tid = threadIdx.x, G = gridDim.x;
    { P0Args a{KIN(0), KIN(2), KIN(3), KIN(8), KIN(9), KIN(10), KIN(11), KIN(12), KIN(14), (bf16*)KWS(WS_WIN), (bf16*)KWS(WS_WBA), (bf16*)KWS(WS_WBM), (bf16*)KWS(WS_WO), (bf16*)KWS(WS_WUP), (bf16*)KWS(WS_WDN), (bf16*)KWS(WS_H), (float*)KWS(WS_RSS1), (float*)KWS(WS_RSS2)};
      p0_prologue(a, lds, tid, G); }
    GSYNC();
    { pg8::Gemm g{(const bf16*)KWS(WS_H), (const bf16*)KWS(WS_WIN), MT, NPROJ_PAD, DM, DM, DM}; pg8::StaticOrder S; S.init(MT, NPROJ_PAD, G, (int)blockIdx.x); EpiProj E{(bf16*)KWS(WS_PROJ)};
      pg8::gemm_phase<EpiProj, pg8::StaticOrder, true, true>(lds, g, S, E); }
    GSYNC();
    { P2Args a{(bf16*)KWS(WS_PROJ), (const int*)karg(1), KIN(4), KIN(5), KIN(6), (bf16*)KWS(WS_QM), (bf16*)KWS(WS_KM), (float*)KWS(WS_GA), (float*)KWS(WS_GB), (float*)KWS(WS_ST), (float*)KWS(WS_KSUM)};
      for (int u = blockIdx.x; u < 256; u += G) p2_unit(a, lds, tid, u); }
    GSYNC();
    { P3Args a{(const bf16*)KWS(WS_PROJ), (const bf16*)KWS(WS_KM), (const float*)KWS(WS_GA), (const float*)KWS(WS_GB), (const float*)KWS(WS_ST), KOUT(), (float*)KWS(WS_NL), (float*)KWS(WS_MC), (float*)KWS(WS_CSC)};
      for (int u = blockIdx.x; u < 1024; u += G) p3_unit(a, lds, tid, u); }
    { AtArgs at{(bf16*)KWS(WS_PROJ), (const float*)KWS(WS_KSUM)};
      for (int p = blockIdx.x; p < 256; p += G) { const int bh = p >> 3, jj = p & 7; attn_unit(at, lds, tid, bh, jj); attn_unit(at, lds, tid, bh, 15 - jj); } }
    GSYNC();
    p4_scan(KOUT(), (float*)KWS(WS_NL), (const float*)KWS(WS_CSC), tid, G);
    GSYNC();
    { P5Args a{(bf16*)KWS(WS_PROJ), (const bf16*)KWS(WS_QM), (const bf16*)KWS(WS_KM), (const float*)KWS(WS_GA), (const float*)KWS(WS_GB), KOUT(), (const float*)KWS(WS_NL), (const float*)KWS(WS_MC), KIN(7)};
      for (int u = blockIdx.x; u < 1024; u += G) p5_unit(a, lds, tid, u); }
    GSYNC();
    { pg8::Gemm g{(const bf16*)KWS(WS_PROJ) + C_QA, (const bf16*)KWS(WS_WBA), MT, DM, 512, NPROJ, 512}; pg8::StaticOrder S; S.init(MT, DM, G, (int)blockIdx.x); EpiGate<false> E{(const bf16*)KWS(WS_PROJ), (bf16*)KWS(WS_MRG), C_GA};
      pg8::gemm_phase<EpiGate<false>, pg8::StaticOrder, true, true>(lds, g, S, E); }
    __syncthreads();
    { pg8::Gemm g{(const bf16*)KWS(WS_PROJ) + C_QM, (const bf16*)KWS(WS_WBM), MT, DM, 512, NPROJ, 512}; pg8::StaticOrder S; S.init(MT, DM, G, (int)blockIdx.x); EpiGate<true> E{(const bf16*)KWS(WS_PROJ), (bf16*)KWS(WS_MRG), C_GM};
      pg8::gemm_phase<EpiGate<true>, pg8::StaticOrder, true, true>(lds, g, S, E); }
    GSYNC();
    { pg8::Gemm g{(const bf16*)KWS(WS_MRG), (const bf16*)KWS(WS_WO), MT, DM, DM, DM, DM}; pg8::StaticOrder S; S.init(MT, DM, G, (int)blockIdx.x); EpiRes1 E{KIN(0), KOUT(), (bf16*)KWS(WS_X1B), (float*)KWS(WS_RSS1)};
      pg8::gemm_phase<EpiRes1, pg8::StaticOrder, true, true>(lds, g, S, E); }
    GSYNC();
    for (int hf = 0; hf < 2; ++hf) {
        { pg8::Gemm g{(const bf16*)KWS(WS_X1B) + (size_t)hf * 8192 * DM, (const bf16*)KWS(WS_WUP), 8192, NUP, DM, DM, DM}; pg8::StaticOrder S; S.init(8192, NUP, G, (int)blockIdx.x); EpiUp E{(bf16*)KWS(WS_U), (const float*)KWS(WS_RSS1) + hf * 8192};
          pg8::gemm_phase<EpiUp, pg8::StaticOrder, true, true>(lds, g, S, E); }
        GSYNC();
        p9_conv((const bf16*)KWS(WS_U), (bf16*)KWS(WS_G) + (size_t)hf * 8192 * DFF, KIN(13), tid, G);
        GSYNC();
    }
    { pg8::Gemm g{(const bf16*)KWS(WS_G), (const bf16*)KWS(WS_WDN), MT, DM, DFF, DFF, DFF}; pg8::StaticOrder S; S.init(MT, DM, G, (int)blockIdx.x); EpiRes2 E{KOUT(), (float*)KWS(WS_RSS2)};
      pg8::gemm_phase<EpiRes2, pg8::StaticOrder, true, true>(lds, g, S, E); }
    GSYNC();
    p11_final(KOUT(), (const float*)KWS(WS_RSS2), KIN(15), tid, G);
}

extern "C" void kernel_launch(void* const* d_in, const int* in_sizes, int n_in, void* d_out, int out_size, void* d_ws, size_t ws_size, hipStream_t stream) {
    static int grid = 0;
    if (grid == 0) {
        if (n_in != 16 || out_size != MT * DM || ws_size < WS_END) { fprintf(stderr, "kernel_launch: unexpected shapes n_in %d out %d ws %zu\n", n_in, out_size, ws_size); grid = -1; return; }
        int dev = 0, cus = 0, per = 0;
        (void)hipGetDevice(&dev); (void)hipDeviceGetAttribute(&cus, hipDeviceAttributeMultiprocessorCount, dev);
        (void)hipFuncSetAttribute((const void*)fwd_mega, hipFuncAttributeMaxDynamicSharedMemorySize, LDS_BYTES);
        (void)hipOccupancyMaxActiveBlocksPerMultiprocessor(&per, (const void*)fwd_mega, 512, LDS_BYTES);
        if (per < 1) per = 1;
        grid = cus * per;
        fprintf(stderr, "kernel_launch: grid %d (cus %d x %d)\n", grid, cus, per);
    }
    if (grid < 0) return;
    Args a{};
    for (int i = 0; i < 16; ++i) a.in[i] = (const float*)d_in[i];
    a.out = (float*)d_out; a.ws = (unsigned char*)d_ws;
    void* kargs[] = {&a};
    hipError_t e = hipLaunchCooperativeKernel((const void*)fwd_mega, dim3(grid), dim3(512), kargs, LDS_BYTES, stream);
    if (e != hipSuccess) fprintf(stderr, "kernel_launch: cooperative launch failed: %s (grid %d)\n", hipGetErrorString(e), grid);
}
```

```cpp
#include <hip/hip_runtime.h>
#include <hip/hip_cooperative_groups.h>
#include <cstdio>
#include <cstdint>
namespace cg = cooperative_groups;
namespace pg8 {
#define PG8_LAS __attribute__((address_space(3)))
typedef unsigned short bf16_t;
typedef short bf16x8 __attribute__((ext_vector_type(8)));
typedef float f32x4 __attribute__((ext_vector_type(4)));
typedef unsigned u32x4 __attribute__((ext_vector_type(4)));
constexpr int BM = 256, BK = 64, HALF = 128, HTB = HALF * BK * 2  , STAGE_BYTES = 8 * HTB, NXCD = 8, WGM = 8;

__host__ __device__ __forceinline__ int lds_byte(int r, int c) { const int st = (r >> 4) * 2 + (c >> 5), rr = r & 15, cc = c & 31, ob = rr * 64 + cc * 2; return st * 1024 + (ob ^ (((ob >> 9) & 1) << 5)); }
__host__ __device__ __forceinline__ void stage_rc(int b, int& R, int& C) { const int st = b / 1024, sb = b % 1024, swz = sb ^ (((sb >> 9) & 1) << 5); R = (st >> 1) * 16 + swz / 64; C = (st & 1) * 32 + (swz % 64) / 2; }
__host__ __device__ __forceinline__ int perm32(int rho) { const int n = rho >> 4, i = rho & 15; return 8 * (i >> 2) + 4 * n + (i & 3); }

struct Unit { int pm, pn; };
struct Gemm { const bf16_t* A; const bf16_t* Bt; int M, N, K, lda, ldb; };

struct StaticOrder {
    int nM, nN, nwg, G, c;
    __host__ __device__ void init(int M, int N, int G_, int c_) { nM = M / BM; nN = N / BM; nwg = nM * nN; G = G_; c = c_; }
    __host__ __device__ bool next(int i, Unit& u) const {
        const long L = (long)i * G + c; if (L >= nwg) return false;
        int wgid = (int)L; { const int q = nwg / NXCD, r = nwg % NXCD, xcd = wgid % NXCD, off = wgid / NXCD; wgid = (xcd < r ? xcd * (q + 1) : r * (q + 1) + (xcd - r) * q) + off; }
        const int nig = WGM * nN, gid = wgid / nig, fm = gid * WGM, gsz = (nM - fm) < WGM ? (nM - fm) : WGM;
        u.pm = fm + ((wgid % nig) % gsz); u.pn = (wgid % nig) / gsz; return true;
    }
    __device__ __forceinline__ void a_ready(const Unit&) const {}
    __device__ __forceinline__ void done(const Unit&) const {}
};

__device__ __forceinline__ unsigned cvt_pk_bf16(float lo, float hi) { unsigned r; asm volatile("v_cvt_pk_bf16_f32 %0, %1, %2" : "=v"(r) : "v"(lo), "v"(hi)); return r; }
template <class Epi, class Sched, bool ALIGN_EPI = false, bool SP2 = false>
__device__ __forceinline__ void gemm_phase(PG8_LAS unsigned char* lds, const Gemm g, const Sched& S, const Epi& E) {
    const int tid = threadIdx.x, wid = __builtin_amdgcn_readfirstlane(tid >> 6), lane = tid & 63, wr = wid >> 2, wc = wid & 3, fr = lane & 15, fq = lane >> 4;
    const int K = g.K, nt = K / BK;
    unsigned voffA[2], voffB[2];
#pragma unroll
    for (int i = 0; i < 2; ++i) { int R, C; stage_rc(tid * 16 + i * 8192, R, C); const int Rb = Epi::PERM ? ((R & ~31) + perm32(R & 31)) : R;
        voffA[i] = (unsigned)(R * g.lda + C) * 2u; voffB[i] = (unsigned)(Rb * g.ldb + C) * 2u; }
    const size_t kstep = (size_t)(BK * 2);
    const size_t hstepA = (size_t)HALF * g.lda * 2, hstepB = (size_t)HALF * g.ldb * 2;
    const size_t tstepA = 2 * hstepA, tstepB = 2 * hstepB;
    const unsigned ldsw = (unsigned)wid * 1024u;
    const int aoff = lds_byte(wr * 64 + fr, fq * 8), boff = lds_byte(wc * 32 + fr, fq * 8);
#define PG8_SA(b, h) (((b) * 2 + (h)) * HTB)
#define PG8_SB(b, h) ((4 + (b) * 2 + (h)) * HTB)
#define PG8_STAGE(bufoff, gbase, voff) do { _Pragma("unroll") for (int _i = 0; _i < 2; ++_i) \
        __builtin_amdgcn_global_load_lds((const unsigned*)((const char*)(gbase) + (voff)[_i]), (PG8_LAS unsigned*)(lds + (bufoff) + ldsw + _i * 8192), 16, 0, 0); } while (0)
#define PG8_LDA(dst, b, h) do { _Pragma("unroll") for (int m = 0; m < 4; ++m) _Pragma("unroll") for (int k = 0; k < 2; ++k) dst[m][k] = *(const PG8_LAS bf16x8*)(lds + PG8_SA(b, h) + aoff + m * 2048 + k * 1024); } while (0)
#define PG8_LDB(dst, b, h) do { _Pragma("unroll") for (int n = 0; n < 2; ++n) _Pragma("unroll") for (int k = 0; k < 2; ++k) dst[n][k] = *(const PG8_LAS bf16x8*)(lds + PG8_SB(b, h) + boff + n * 2048 + k * 1024); } while (0)
#define PG8_MMA(ai, bj, At, Bt) do { __builtin_amdgcn_s_setprio(1); _Pragma("unroll") for (int m = 0; m < 4; ++m) _Pragma("unroll") for (int n = 0; n < 2; ++n) _Pragma("unroll") for (int k = 0; k < 2; ++k) \
        acc[ai][bj][m][n] = __builtin_amdgcn_mfma_f32_16x16x32_bf16(Bt[n][k], At[m][k], acc[ai][bj][m][n], 0, 0, 0); __builtin_amdgcn_s_setprio(0); } while (0)
#define PG8_WAIT_V(n) asm volatile("s_waitcnt vmcnt(" #n ")" ::: "memory")
#define PG8_WAIT_L(n) asm volatile("s_waitcnt lgkmcnt(" #n ")" ::: "memory")
#define PG8_BAR __builtin_amdgcn_s_barrier()
#define PG8_SCHED __builtin_amdgcn_sched_barrier(0)
    Unit cur, nxt; int ui = 0;
    if (!S.next(0, cur)) return;
    f32x4 acc[2][2][4][2];
#pragma unroll
    for (int a = 0; a < 2; ++a)
#pragma unroll
        for (int b = 0; b < 2; ++b)
#pragma unroll
            for (int m = 0; m < 4; ++m)
#pragma unroll
                for (int n = 0; n < 2; ++n) acc[a][b][m][n] = (f32x4){0.f, 0.f, 0.f, 0.f};
    bf16x8 At[4][2], B0[2][2], B1[2][2];
    const char* cA = (const char*)g.A + (size_t)cur.pm * tstepA; const char* cB = (const char*)g.Bt + (size_t)cur.pn * tstepB;
    S.a_ready(cur);
    if constexpr (SP2) {
        PG8_STAGE(PG8_SB(0, 0), cB, voffB); PG8_STAGE(PG8_SB(0, 1), cB + hstepB, voffB); PG8_STAGE(PG8_SA(0, 0), cA, voffA); PG8_STAGE(PG8_SA(0, 1), cA + hstepA, voffA);
        if (wr == 1) PG8_BAR;
        PG8_WAIT_V(2); PG8_BAR;
        PG8_STAGE(PG8_SB(1, 0), cB + kstep, voffB); PG8_STAGE(PG8_SA(1, 0), cA + kstep, voffA); PG8_STAGE(PG8_SB(1, 1), cB + hstepB + kstep, voffB);
        PG8_WAIT_V(6); PG8_BAR;
    } else {
        PG8_STAGE(PG8_SB(0, 0), cB, voffB); PG8_STAGE(PG8_SA(0, 0), cA, voffA); PG8_STAGE(PG8_SB(0, 1), cB + hstepB, voffB); PG8_STAGE(PG8_SA(0, 1), cA + hstepA, voffA);
        if (wr == 1) PG8_BAR;
        PG8_WAIT_V(4); PG8_BAR;
        PG8_STAGE(PG8_SB(1, 0), cB + kstep, voffB); PG8_STAGE(PG8_SA(1, 0), cA + kstep, voffA); PG8_STAGE(PG8_SB(1, 1), cB + hstepB + kstep, voffB);
        PG8_WAIT_V(6); PG8_BAR;
    }
    for (;;) {
        const bool has_next = S.next(ui + 1, nxt);
        const char* nA = has_next ? (const char*)g.A + (size_t)nxt.pm * tstepA : cA; const char* nB = has_next ? (const char*)g.Bt + (size_t)nxt.pn * tstepB : cB;
        for (int t = 0; t < nt; t += 2) {
            const bool last = (t == nt - 2);
            const char* a1 = cA + (size_t)(t + 1) * kstep;
            const char* a2 = last ? nA : cA + (size_t)(t + 2) * kstep; const char* b2 = last ? nB : cB + (size_t)(t + 2) * kstep;
            const char* a3 = a2 + kstep; const char* b3 = b2 + kstep;
            if (last && has_next) S.a_ready(nxt);
            if constexpr (SP2) {
            PG8_LDB(B0, 0, 0); PG8_LDB(B1, 0, 1); PG8_SCHED; PG8_LDA(At, 0, 0); PG8_STAGE(PG8_SA(1, 1), a1 + hstepA, voffA);
            PG8_WAIT_V(8); PG8_WAIT_L(0); PG8_BAR; PG8_MMA(0, 0, At, B0); PG8_MMA(0, 1, At, B1); PG8_BAR; PG8_SCHED;
            PG8_LDA(At, 0, 1); PG8_STAGE(PG8_SB(0, 0), b2, voffB); PG8_STAGE(PG8_SB(0, 1), b2 + hstepB, voffB); PG8_STAGE(PG8_SA(0, 0), a2, voffA);
            PG8_WAIT_V(8); PG8_WAIT_L(0); PG8_BAR; PG8_MMA(1, 0, At, B0); PG8_MMA(1, 1, At, B1); PG8_BAR; PG8_SCHED;
            PG8_LDB(B0, 1, 0); PG8_LDB(B1, 1, 1); PG8_SCHED; PG8_LDA(At, 1, 0); PG8_STAGE(PG8_SA(0, 1), a2 + hstepA, voffA);
            PG8_WAIT_V(8); PG8_WAIT_L(0); PG8_BAR; PG8_MMA(0, 0, At, B0); PG8_MMA(0, 1, At, B1); PG8_BAR; PG8_SCHED;
            PG8_LDA(At, 1, 1); PG8_STAGE(PG8_SB(1, 0), b3, voffB); PG8_STAGE(PG8_SB(1, 1), b3 + hstepB, voffB); PG8_STAGE(PG8_SA(1, 0), a3, voffA);
            PG8_WAIT_V(8); PG8_WAIT_L(0); PG8_BAR; PG8_MMA(1, 0, At, B0); PG8_MMA(1, 1, At, B1); PG8_BAR; PG8_SCHED;
            } else {
            PG8_LDB(B0, 0, 0); PG8_SCHED; PG8_LDA(At, 0, 0); PG8_STAGE(PG8_SA(1, 1), a1 + hstepA, voffA);
            PG8_WAIT_L(8); PG8_BAR; PG8_WAIT_L(0); PG8_MMA(0, 0, At, B0); PG8_BAR; PG8_SCHED;
            PG8_LDB(B1, 0, 1); PG8_STAGE(PG8_SB(0, 0), b2, voffB);
            PG8_BAR; PG8_WAIT_L(0); PG8_MMA(0, 1, At, B1); PG8_BAR;
            PG8_LDA(At, 0, 1); PG8_STAGE(PG8_SA(0, 0), a2, voffA);
            PG8_BAR; PG8_WAIT_L(0); PG8_MMA(1, 0, At, B0); PG8_BAR; PG8_SCHED;
            PG8_STAGE(PG8_SB(0, 1), b2 + hstepB, voffB);
            PG8_WAIT_V(6); PG8_BAR; PG8_MMA(1, 1, At, B1); PG8_BAR;
            PG8_LDB(B0, 1, 0); PG8_SCHED; PG8_LDA(At, 1, 0); PG8_STAGE(PG8_SA(0, 1), a2 + hstepA, voffA);
            PG8_WAIT_L(8); PG8_BAR; PG8_WAIT_L(0); PG8_MMA(0, 0, At, B0); PG8_BAR; PG8_SCHED;
            PG8_LDB(B1, 1, 1); PG8_STAGE(PG8_SB(1, 0), b3, voffB);
            PG8_BAR; PG8_WAIT_L(0); PG8_MMA(0, 1, At, B1); PG8_BAR;
            PG8_LDA(At, 1, 1); PG8_STAGE(PG8_SA(1, 0), a3, voffA);
            PG8_BAR; PG8_WAIT_L(0); PG8_MMA(1, 0, At, B0); PG8_BAR; PG8_SCHED;
            PG8_STAGE(PG8_SB(1, 1), b3 + hstepB, voffB);
            PG8_WAIT_V(6); PG8_BAR; PG8_MMA(1, 1, At, B1); PG8_BAR;
            }
        }
        if constexpr (ALIGN_EPI) { if (wr == 0) PG8_BAR; }
        if constexpr (!Epi::AFTER_DRAIN) { E(acc, cur, wr, wc, fr, fq); S.done(cur); }
        if (!has_next) break;
#pragma unroll
        for (int a = 0; a < 2; ++a)
#pragma unroll
            for (int b = 0; b < 2; ++b)
#pragma unroll
                for (int m = 0; m < 4; ++m)
#pragma unroll
                    for (int n = 0; n < 2; ++n) acc[a][b][m][n] = (f32x4){0.f, 0.f, 0.f, 0.f};
        cur = nxt; cA = nA; cB = nB; ++ui;
        if constexpr (ALIGN_EPI) { if (wr == 1) PG8_BAR; }
    }
    PG8_WAIT_V(0);
    if constexpr (!ALIGN_EPI) { if (wr == 0) PG8_BAR; }
    PG8_BAR;
    if constexpr (Epi::AFTER_DRAIN) { E.fused(acc, cur, wr, wc, fr, fq, lds, wid, lane); S.done(cur); }
#undef PG8_SA
#undef PG8_SB
#undef PG8_STAGE
#undef PG8_LDA
#undef PG8_LDB
#undef PG8_MMA
#undef PG8_WAIT_V
#undef PG8_WAIT_L
#undef PG8_BAR
#undef PG8_SCHED
}
}

#define LAS __attribute__((address_space(3)))
typedef unsigned short bf16;
typedef short bf16x8 __attribute__((ext_vector_type(8)));
typedef float f32x4 __attribute__((ext_vector_type(4)));
typedef float f32x16 __attribute__((ext_vector_type(16)));
typedef unsigned u32x4 __attribute__((ext_vector_type(4)));
typedef unsigned u32x2 __attribute__((ext_vector_type(2)));
constexpr int NB = 4, SEQ = 4096, DM = 1024, MT = NB * SEQ;
constexpr int NPROJ = 5640, NPROJ_PAD = 5888, DFF = 2816, NUP = 5632;
constexpr int C_QA = 0, C_KA = 512, C_VA = 1024, C_QM = 1536, C_KM = 2048, C_VM = 2560, C_OM = 3072, C_GA = 3584, C_GM = 4608, C_I = 5632, C_F = 5636;
constexpr float EPS = 1e-6f;
constexpr float QSCALE = 0.125f * 1.4426950408889634f;
constexpr float NEGF = -1e30f;
constexpr size_t MiB = 1u << 20;
constexpr size_t WS_RSS1 = 0, WS_RSS2 = 64 * 1024, WS_GA = 128 * 1024, WS_GB = 384 * 1024, WS_ST = 640 * 1024, WS_MC = 648 * 1024, WS_CSC = 652 * 1024,
                 WS_KSUM = 1 * MiB, WS_NL = 2 * MiB, WS_BAR = 3 * MiB;
constexpr size_t WS_WIN = 4 * MiB, WS_WUP = WS_WIN + 23 * MiB / 2, WS_WDN = WS_WUP + 11 * MiB, WS_WO = 32 * MiB, WS_WBA = 34 * MiB, WS_WBM = 35 * MiB;
constexpr size_t WS_H = 36 * MiB;
constexpr size_t WS_QM = WS_H, WS_KM = WS_H + 16 * MiB, WS_MRG = WS_H, WS_U = WS_H;
constexpr size_t WS_PROJ = 68 * MiB;
constexpr size_t WS_G = 124 * MiB;
constexpr size_t WS_X1B = 224 * MiB;
constexpr size_t WS_END = 256 * MiB;
constexpr int LDS_BYTES = 147456;

__device__ __forceinline__ float bf2f(unsigned short v) { return __uint_as_float((unsigned)v << 16); }
__device__ __forceinline__ unsigned short f2bf(float f) { unsigned u = __float_as_uint(f); return (unsigned short)((u + 0x7fffu + ((u >> 16) & 1u)) >> 16); }
__device__ __forceinline__ unsigned pk2(float lo, float hi) { return (unsigned)f2bf(lo) | ((unsigned)f2bf(hi) << 16); }
__device__ __forceinline__ float bflo(unsigned w) { return __uint_as_float(w << 16); }
__device__ __forceinline__ float bfhi(unsigned w) { return __uint_as_float(w & 0xffff0000u); }
__device__ __forceinline__ float sigmoidf_(float v) { return 1.0f / (1.0f + __expf(-v)); }
__device__ __forceinline__ float siluf_(float v) { return v / (1.0f + __expf(-v)); }
__device__ __forceinline__ float red32_sum(float v) { v += __shfl_xor(v, 1); v += __shfl_xor(v, 2); v += __shfl_xor(v, 4); v += __shfl_xor(v, 8); v += __shfl_xor(v, 16); return v; }
__device__ __forceinline__ float wave_sum(float v) {
#pragma unroll
    for (int o = 1; o < 64; o <<= 1) v += __shfl_xor(v, o);
    return v;
}
__device__ __forceinline__ float wave_max(float v) {
#pragma unroll
    for (int o = 1; o < 64; o <<= 1) v = fmaxf(v, __shfl_xor(v, o));
    return v;
}
__device__ __forceinline__ f32x16 mma32(f32x16 acc, const LAS bf16* A, int lda, const LAS bf16* B, int ldb, int ksteps, int lane) {
    const int r = lane & 31, h = lane >> 5;
    const LAS bf16* ap = A + r * lda + 8 * h; const LAS bf16* bp = B + r * ldb + 8 * h;
    for (int ks = 0; ks < ksteps; ++ks) {
        const bf16x8 a = *(const LAS bf16x8*)(ap + 16 * ks), b = *(const LAS bf16x8*)(bp + 16 * ks);
        acc = __builtin_amdgcn_mfma_f32_32x32x16_bf16(a, b, acc, 0, 0, 0);
    }
    return acc;
}
__device__ __forceinline__ int crow(int i, int h) { return (i & 3) + 8 * (i >> 2) + 4 * h; }
using pg8::Unit; using pg8::cvt_pk_bf16;
typedef const f32x4 (&AccRef)[2][2][4][2];
__device__ __forceinline__ u32x4 pack8(f32x4 a, f32x4 b) { u32x4 w; w.x = cvt_pk_bf16(a[0], a[1]); w.y = cvt_pk_bf16(a[2], a[3]); w.z = cvt_pk_bf16(b[0], b[1]); w.w = cvt_pk_bf16(b[2], b[3]); return w; }
__device__ __forceinline__ void unpack8(u32x4 w, f32x4& a, f32x4& b) { a = (f32x4){bflo(w.x), bfhi(w.x), bflo(w.y), bfhi(w.y)}; b = (f32x4){bflo(w.z), bfhi(w.z), bflo(w.w), bfhi(w.w)}; }
__device__ __forceinline__ f32x4 sig4(f32x4 v) { return (f32x4){sigmoidf_(v[0]), sigmoidf_(v[1]), sigmoidf_(v[2]), sigmoidf_(v[3])}; }
#define EPI_LOOP_BEGIN  _Pragma("unroll") for (int ai = 0; ai < 2; ++ai) _Pragma("unroll") for (int m = 0; m < 4; ++m) { const int row = u.pm * 256 + ai * 128 + wr * 64 + m * 16 + fr;
#define EPI_COL(bj) (u.pn * 256 + (bj) * 128 + wc * 32 + 8 * fq)
struct EpiProj { static constexpr bool PERM = true, AFTER_DRAIN = false; bf16* O;
    __device__ __forceinline__ void operator()(AccRef acc, const Unit& u, int wr, int wc, int fr, int fq) const {
        EPI_LOOP_BEGIN
#pragma unroll
            for (int bj = 0; bj < 2; ++bj) { const int col = EPI_COL(bj); if (col < NPROJ) *(u32x4*)(O + (size_t)row * NPROJ + col) = pack8(acc[ai][bj][m][0], acc[ai][bj][m][1]); }
        }
    }
};
template <bool ADD> struct EpiGate { static constexpr bool PERM = true, AFTER_DRAIN = false; const bf16* P; bf16* T; int gcol0;
    __device__ __forceinline__ void operator()(AccRef acc, const Unit& u, int wr, int wc, int fr, int fq) const {
        EPI_LOOP_BEGIN
#pragma unroll
            for (int bj = 0; bj < 2; ++bj) { const int col = EPI_COL(bj);
                const u32x4 gw = *(const u32x4*)(P + (size_t)row * NPROJ + gcol0 + col); f32x4 g0, g1; unpack8(gw, g0, g1);
                f32x4 v0 = acc[ai][bj][m][0] * sig4(g0), v1 = acc[ai][bj][m][1] * sig4(g1);
                bf16* tp = T + (size_t)row * DM + col;
                if (ADD) { f32x4 t0, t1; unpack8(*(const u32x4*)tp, t0, t1); v0 += t0; v1 += t1; }
                *(u32x4*)tp = pack8(v0, v1); }
        }
    }
};
struct EpiRes1 { static constexpr bool PERM = true, AFTER_DRAIN = false; const float* x; float* x1; bf16* x1b; float* rss;
    __device__ __forceinline__ void operator()(AccRef acc, const Unit& u, int wr, int wc, int fr, int fq) const {
        EPI_LOOP_BEGIN
            float ss = 0.f;
#pragma unroll
            for (int bj = 0; bj < 2; ++bj) { const int col = EPI_COL(bj); const size_t off = (size_t)row * DM + col;
                const f32x4 v0 = acc[ai][bj][m][0] + *(const f32x4*)(x + off), v1 = acc[ai][bj][m][1] + *(const f32x4*)(x + off + 4);
                *(f32x4*)(x1 + off) = v0; *(f32x4*)(x1 + off + 4) = v1; *(u32x4*)(x1b + off) = pack8(v0, v1);
                ss += (v0[0] * v0[0] + v0[1] * v0[1]) + (v0[2] * v0[2] + v0[3] * v0[3]) + (v1[0] * v1[0] + v1[1] * v1[1]) + (v1[2] * v1[2] + v1[3] * v1[3]); }
            ss += __shfl_xor(ss, 16); ss += __shfl_xor(ss, 32);
            if (fq == 0) unsafeAtomicAdd(rss + row, ss);
        }
    }
};
struct EpiUp { static constexpr bool PERM = true, AFTER_DRAIN = false; bf16* U; const float* rss;
    __device__ __forceinline__ void operator()(AccRef acc, const Unit& u, int wr, int wc, int fr, int fq) const {
        EPI_LOOP_BEGIN
            const float rs = rsqrtf(rss[row] * (1.0f / DM) + EPS);
#pragma unroll
            for (int bj = 0; bj < 2; ++bj) { const int col = EPI_COL(bj); *(u32x4*)(U + (size_t)row * NUP + col) = pack8(acc[ai][bj][m][0] * rs, acc[ai][bj][m][1] * rs); }
        }
    }
};
struct EpiRes2 { static constexpr bool PERM = true, AFTER_DRAIN = false; float* xio; float* rss;
    __device__ __forceinline__ void operator()(AccRef acc, const Unit& u, int wr, int wc, int fr, int fq) const {
        EPI_LOOP_BEGIN
            float ss = 0.f;
#pragma unroll
            for (int bj = 0; bj < 2; ++bj) { const int col = EPI_COL(bj); const size_t off = (size_t)row * DM + col;
                const f32x4 v0 = acc[ai][bj][m][0] + *(const f32x4*)(xio + off), v1 = acc[ai][bj][m][1] + *(const f32x4*)(xio + off + 4);
                *(f32x4*)(xio + off) = v0; *(f32x4*)(xio + off + 4) = v1;
                ss += (v0[0] * v0[0] + v0[1] * v0[1]) + (v0[2] * v0[2] + v0[3] * v0[3]) + (v1[0] * v1[0] + v1[1] * v1[1]) + (v1[2] * v1[2] + v1[3] * v1[3]); }
            ss += __shfl_xor(ss, 16); ss += __shfl_xor(ss, 32);
            if (fq == 0) unsafeAtomicAdd(rss + row, ss);
        }
    }
};
template <int MODE> __device__ __forceinline__ void transpose_item(const float* W, int K, int N, bf16* WT, LAS float* scr, int item, int lane, const float* gk) {
    const int nblk = (N + 31) / 32, kb = item / nblk, nb = item % nblk, k0 = 64 * kb, n0 = 32 * nb;
#pragma unroll 8
    for (int i = 0; i < 32; ++i) { const int kk = 2 * i + (lane >> 5), n = n0 + (lane & 31);
        float v = (n < N) ? W[(size_t)(k0 + kk) * N + n] : 0.f; if (MODE == 2) v *= gk[k0 + kk]; scr[kk * 33 + (lane & 31)] = v; }
    asm volatile("s_waitcnt lgkmcnt(0)" ::: "memory");
    const int c = lane & 7;
#pragma unroll
    for (int j = 0; j < 4; ++j) { const int nl = (lane >> 3) + 8 * j, n = n0 + nl; const LAS float* s = scr + (8 * c) * 33 + nl;
        if (n < N) { int dn = n; if (MODE == 1) dn = (n < 3584) ? n : ((n < 3592) ? (C_I + (n - 3584)) : (n - 8));
            u32x4 o; o.x = pk2(s[0 * 33], s[1 * 33]); o.y = pk2(s[2 * 33], s[3 * 33]); o.z = pk2(s[4 * 33], s[5 * 33]); o.w = pk2(s[6 * 33], s[7 * 33]);
            *(u32x4*)(WT + (size_t)dn * K + k0 + 8 * c) = o; } }
    asm volatile("s_waitcnt lgkmcnt(0)" ::: "memory");
}
struct P0Args { const float *x, *g1, *w_in, *wba, *wbm, *wo, *g2, *wup, *wdn; bf16 *WinT, *WbaT, *WbmT, *WoT, *WupT, *WdnT, *H; float *rss1, *rss2; };
__device__ __forceinline__ void p0_prologue(const P0Args& a, LAS unsigned char* lds, int tid, int G) {
    const int lane = tid & 63, wave = tid >> 6;
    LAS float* scr = (LAS float*)(lds + wave * 16384);
    const int gw = blockIdx.x * 8 + wave, NGW = G * 8;
    constexpr int I_IN = (DM / 64) * ((NPROJ + 31) / 32), I_BA = (512 / 64) * (DM / 32), I_O = (DM / 64) * (DM / 32), I_UP = (DM / 64) * (NUP / 32), I_DN = (DFF / 64) * (DM / 32);
    constexpr int NITEMS = I_IN + 2 * I_BA + I_O + I_UP + I_DN;
    for (int it = gw; it < NITEMS; it += NGW) {
        int r = it;
        if (r < I_IN) { transpose_item<1>(a.w_in, DM, NPROJ, a.WinT, scr, r, lane, nullptr); continue; } r -= I_IN;
        if (r < I_BA) { transpose_item<0>(a.wba, 512, DM, a.WbaT, scr, r, lane, nullptr); continue; } r -= I_BA;
        if (r < I_BA) { transpose_item<0>(a.wbm, 512, DM, a.WbmT, scr, r, lane, nullptr); continue; } r -= I_BA;
        if (r < I_O) { transpose_item<0>(a.wo, DM, DM, a.WoT, scr, r, lane, nullptr); continue; } r -= I_O;
        if (r < I_UP) { transpose_item<2>(a.wup, DM, NUP, a.WupT, scr, r, lane, a.g2); continue; } r -= I_UP;
        transpose_item<0>(a.wdn, DFF, DM, a.WdnT, scr, r, lane, nullptr);
    }
    for (int m = gw; m < MT; m += NGW) {
        const f32x4* xr = (const f32x4*)(a.x + (size_t)m * DM) + lane; f32x4 v[4]; float s = 0.f;
#pragma unroll
        for (int j = 0; j < 4; ++j) { v[j] = xr[64 * j]; s += (v[j][0] * v[j][0] + v[j][1] * v[j][1]) + (v[j][2] * v[j][2] + v[j][3] * v[j][3]); }
        const float rstd = rsqrtf(wave_sum(s) * (1.0f / DM) + EPS);
        u32x2* o8 = (u32x2*)(a.H + (size_t)m * DM) + lane;
#pragma unroll
        for (int j = 0; j < 4; ++j) { const f32x4 g = *((const f32x4*)a.g1 + lane + 64 * j); u32x2 w; w.x = pk2(v[j][0] * rstd * g[0], v[j][1] * rstd * g[1]); w.y = pk2(v[j][2] * rstd * g[2], v[j][3] * rstd * g[3]); o8[64 * j] = w; }
    }
    for (int i = blockIdx.x * 512 + tid; i < MT; i += G * 512) { a.rss1[i] = 0.f; a.rss2[i] = 0.f; }
}

struct P2Args { bf16* P; const int* pos; const float *conv_m, *i_bias, *f_bias; bf16 *QM, *KM; float *GA, *GB, *ST, *KSUM; };
__device__ __forceinline__ void p2_unit(const P2Args& a, LAS unsigned char* lds, int tid, int cu) {
    const int lane = tid & 63, wave = tid >> 6;
    const int b = cu >> 6, c = cu & 63, t0 = b * SEQ + c * 64;
    LAS float* cs = (LAS float*)lds;
    LAS float* sn = cs + 2048;
    LAS float* ks2 = sn + 2048;
    for (int e = tid; e < 2048; e += 512) { const int tok = e >> 5, i = e & 31; const float invf = powf(10000.0f, -(float)i * (1.0f / 32.0f));
        const float ang = (float)a.pos[t0 + tok] * invf; float sv, cv; sincosf(ang, &sv, &cv); cs[e] = cv; sn[e] = sv; }
    __syncthreads();
    {
        const int isk = tid >> 8, hh = (tid & 255) >> 5, i = tid & 31; const int col = (isk ? C_KA : C_QA) + hh * 64 + i; const float sc = isk ? 1.0f : QSCALE;
        float s1 = 0.f, s2 = 0.f;
        for (int tok = 0; tok < 64; ++tok) { bf16* p = a.P + (size_t)(t0 + tok) * NPROJ + col; const float v1 = bf2f(p[0]), v2 = bf2f(p[32]);
            const float cv = cs[tok * 32 + i], sv = sn[tok * 32 + i]; const float o1 = v1 * cv - v2 * sv, o2 = v2 * cv + v1 * sv;
            p[0] = f2bf(o1 * sc); p[32] = f2bf(o2 * sc); s1 += o1; s2 += o2; }
        if (isk) { float* kd = a.KSUM + ((size_t)(b * 8 + hh) * 64 + c) * 64; kd[i] = s1; kd[i + 32] = s2; }
    }
    {
#pragma unroll
        for (int qk = 0; qk < 2; ++qk) { const int ch = qk * 512 + tid; const int col = (qk ? C_KM : C_QM) + tid;
            const float w0 = a.conv_m[ch], w1 = a.conv_m[1024 + ch], w2 = a.conv_m[2048 + ch], w3 = a.conv_m[3072 + ch];
            float x0 = 0.f, x1 = 0.f, x2 = 0.f;
            if (c > 0) { x0 = bf2f(a.P[(size_t)(t0 - 3) * NPROJ + col]); x1 = bf2f(a.P[(size_t)(t0 - 2) * NPROJ + col]); x2 = bf2f(a.P[(size_t)(t0 - 1) * NPROJ + col]); }
            bf16* dst = (qk ? a.KM : a.QM) + (size_t)t0 * 512 + tid; const float osc = qk ? 0.08838834764831845f : 1.0f;
            for (int tok = 0; tok < 64; ++tok) { const float x3 = bf2f(a.P[(size_t)(t0 + tok) * NPROJ + col]);
                const float y = w0 * x0 + w1 * x1 + w2 * x2 + w3 * x3; dst[(size_t)tok * 512] = f2bf(siluf_(y) * osc); x0 = x1; x1 = x2; x2 = x3; } }
    }
    if (wave < 4) {
        const int hh = wave; const size_t prow = (size_t)(t0 + lane) * NPROJ;
        const float av = bf2f(a.P[prow + C_I + hh]) + a.i_bias[hh]; const float fp = bf2f(a.P[prow + C_F + hh]) + a.f_bias[hh];
        const float lf = fminf(fp, 0.f) - log1pf(__expf(-fabsf(fp)));
        float bc = lf;
#pragma unroll
        for (int o = 1; o < 64; o <<= 1) { const float t = __shfl_up(bc, o); if (lane >= o) bc += t; }
        const float blast = __shfl(bc, 63); const float md = wave_max(blast - bc + av);
        const size_t gi = (size_t)(b * 4 + hh) * SEQ + c * 64 + lane; a.GA[gi] = av; a.GB[gi] = bc;
        if (lane == 0) { float* st = a.ST + ((size_t)(b * 4 + hh) * 64 + c) * 2; st[0] = blast; st[1] = md; }
    }
    __syncthreads();
}
struct P3Args { const bf16 *P, *KM; const float *GA, *GB, *ST; float *CT, *NL, *MC, *CSC; };
__device__ __forceinline__ void p3_unit(const P3Args& a, LAS unsigned char* lds, int tid, int un) {
    const int lane = tid & 63, wave = tid >> 6;
    const int bh = un >> 6, c = un & 63, b = bh >> 2, hh = bh & 3, t0 = b * SEQ + c * 64;
    LAS bf16* KT = (LAS bf16*)lds;
    LAS bf16* VT = KT + 128 * 72;
    LAS float* wk = (LAS float*)(VT + 128 * 72);
    LAS float* msc = wk + 64;
    if (wave == 0) {
        const float* st = a.ST + (size_t)bh * 128; const float bl = st[2 * lane], md = st[2 * lane + 1];
        float m = 0.f;
        for (int j = 0; j < c; ++j) m = fmaxf(__shfl(bl, j) + m, __shfl(md, j));
        const float blc = __shfl(bl, c), mdc = __shfl(md, c); const float mnew = fmaxf(blc + m, mdc);
        const size_t gi = (size_t)bh * SEQ + c * 64 + lane;
        wk[lane] = __expf(blc - a.GB[gi] + a.GA[gi] - mnew);
        if (lane == 0) { a.MC[un] = m; a.CSC[un] = __expf(blc + m - mnew); }
    }
    __syncthreads();
#pragma unroll
    for (int k = 0; k < 2; ++k) { const int q = tid + 512 * k, s = q >> 4, dc = (q & 15) * 8;
        const u32x4 kw = *(const u32x4*)(a.KM + (size_t)(t0 + s) * 512 + hh * 128 + dc);
        const u32x4 vw = *(const u32x4*)(a.P + (size_t)(t0 + s) * NPROJ + C_VM + hh * 128 + dc);
        const float w = wk[s]; f32x4 k0, k1; unpack8(kw, k0, k1);
#pragma unroll
        for (int e = 0; e < 4; ++e) { KT[(dc + e) * 72 + s] = f2bf(k0[e] * w); KT[(dc + 4 + e) * 72 + s] = f2bf(k1[e] * w); }
        const unsigned vv[4] = {vw.x, vw.y, vw.z, vw.w};
#pragma unroll
        for (int e = 0; e < 4; ++e) { VT[(dc + 2 * e) * 72 + s] = (bf16)(vv[e] & 0xffffu); VT[(dc + 2 * e + 1) * 72 + s] = (bf16)(vv[e] >> 16); } }
    __syncthreads();
    if (tid < 128) { float s = 0.f; for (int j = 0; j < 64; ++j) s += bf2f(KT[tid * 72 + j]); a.NL[(size_t)un * 128 + tid] = s; }
    {
        const int vt = wave >> 1, r = lane & 31, h = lane >> 5;
#pragma unroll
        for (int dd = 0; dd < 2; ++dd) { const int dt = 2 * (wave & 1) + dd; f32x16 acc; for (int i = 0; i < 16; ++i) acc[i] = 0.f;
            acc = mma32(acc, VT + 32 * vt * 72, 72, KT + 32 * dt * 72, 72, 4, lane);
            float* o = a.CT + (size_t)un * 16384 + 32 * dt + r;
#pragma unroll
            for (int i = 0; i < 16; ++i) o[(size_t)(32 * vt + crow(i, h)) * 128] = acc[i]; }
    }
    __syncthreads();
}
__device__ __forceinline__ void p4_scan(float* CT, float* NL, const float* CSC, int tid, int G) {
    const int gt = blockIdx.x * 512 + tid, NT = G * 512;
    for (int it = gt; it < 16 * 8192; it += NT) { const int bh = it >> 13, e2 = it & 8191;
        float* p = CT + (size_t)bh * 64 * 16384 + 2 * e2; const float* cs = CSC + bh * 64; float c0 = 0.f, c1 = 0.f;
#pragma unroll 8
        for (int c = 0; c < 64; ++c) { const float2 l = *(const float2*)(p + (size_t)c * 16384); *(float2*)(p + (size_t)c * 16384) = make_float2(c0, c1); const float s = cs[c]; c0 = s * c0 + l.x; c1 = s * c1 + l.y; } }
    for (int it = gt; it < 16 * 128; it += NT) { const int bh = it >> 7, e = it & 127; float* p = NL + (size_t)bh * 64 * 128 + e; const float* cs = CSC + bh * 64; float n0 = 0.f;
        for (int c = 0; c < 64; ++c) { const float l = p[c * 128]; p[c * 128] = n0; n0 = cs[c] * n0 + l; } }
}
struct P5Args { bf16* P; const bf16 *QM, *KM; const float *GA, *GB, *CT, *NL, *MC, *ng; };
__device__ __forceinline__ void p5_unit(const P5Args& a, LAS unsigned char* lds, int tid, int un) {
    const int lane = tid & 63, wave = tid >> 6, r = lane & 31, h = lane >> 5;
    const int bh = un >> 6, c = un & 63, b = bh >> 2, hh = bh & 3, t0 = b * SEQ + c * 64;
    LAS bf16* Qs = (LAS bf16*)lds;
    LAS bf16* Ks = Qs + 64 * 136;
    LAS bf16* VT = Ks + 64 * 136;
    LAS bf16* Et = VT + 128 * 72;
    LAS bf16* Ps = Et + 128 * 136;
    LAS float* fa = (LAS float*)(Ps + 64 * 72);
    LAS float* fb = fa + 64;
    LAS float* fmt = fb + 64;
    LAS float* fwi = fmt + 64;
    LAS float* fqn = fwi + 64;
    LAS float* frs = fqn + 64;
    LAS float* fss = frs + 128;
    LAS float* fnp = fss + 256;
    const float mc = a.MC[un];
#pragma unroll
    for (int k = 0; k < 2; ++k) { const int q = tid + 512 * k, s = q >> 4, dc = (q & 15) * 8;
        *(LAS u32x4*)(Qs + s * 136 + dc) = *(const u32x4*)(a.QM + (size_t)(t0 + s) * 512 + hh * 128 + dc);
        *(LAS u32x4*)(Ks + s * 136 + dc) = *(const u32x4*)(a.KM + (size_t)(t0 + s) * 512 + hh * 128 + dc);
        const u32x4 vw = *(const u32x4*)(a.P + (size_t)(t0 + s) * NPROJ + C_VM + hh * 128 + dc);
        const unsigned vv[4] = {vw.x, vw.y, vw.z, vw.w};
#pragma unroll
        for (int e = 0; e < 4; ++e) { VT[(dc + 2 * e) * 72 + s] = (bf16)(vv[e] & 0xffffu); VT[(dc + 2 * e + 1) * 72 + s] = (bf16)(vv[e] >> 16); } }
#pragma unroll
    for (int k = 0; k < 4; ++k) { const int q = tid + 512 * k, v = q >> 4, dc = (q & 15) * 8; const float* src = a.CT + (size_t)un * 16384 + v * 128 + dc;
        const f32x4 e0 = *(const f32x4*)src, e1 = *(const f32x4*)(src + 4); *(LAS u32x4*)(Et + v * 136 + dc) = pack8(e0, e1); }
    if (tid < 128) fnp[tid] = a.NL[(size_t)un * 128 + tid];
    if (tid < 64) { const size_t gi = (size_t)bh * SEQ + c * 64 + tid; fa[tid] = a.GA[gi]; fb[tid] = a.GB[gi]; }
    __syncthreads();
    if (tid < 64) { const int l = tid; float pm = NEGF; for (int s = 0; s <= l; ++s) pm = fmaxf(pm, fa[s] - fb[s]);
        const float bl = fb[l], mt = fmaxf(bl + mc, bl + pm); fmt[l] = mt; fwi[l] = __expf(bl + mc - mt);
        float qn = 0.f; for (int d = 0; d < 128; ++d) qn += bf2f(Qs[l * 136 + d]) * fnp[d]; fqn[l] = qn; }
    __syncthreads();
    if (wave < 4) {
        const int lt = wave & 1, st = wave >> 1; f32x16 acc; for (int i = 0; i < 16; ++i) acc[i] = 0.f;
        acc = mma32(acc, Qs + 32 * lt * 136, 136, Ks + 32 * st * 136, 136, 8, lane);
        const int s = 32 * st + r; const float as = fa[s], bs = fb[s];
#pragma unroll
        for (int i = 0; i < 16; ++i) { const int l = 32 * lt + crow(i, h);
            float sc = 0.f; if (s <= l) sc = __expf(fb[l] - bs + as - fmt[l]) * acc[i];
            const bf16 sb = f2bf(sc); Ps[l * 72 + s] = sb; const float rsum = red32_sum(bf2f(sb)); if (r == 0) frs[st * 64 + l] = rsum; }
    }
    __syncthreads();
    {
        const int lt = wave & 1, vt = wave >> 1; f32x16 ae, as_; for (int i = 0; i < 16; ++i) { ae[i] = 0.f; as_[i] = 0.f; }
        ae = mma32(ae, Qs + 32 * lt * 136, 136, Et + 32 * vt * 136, 136, 8, lane);
        as_ = mma32(as_, Ps + 32 * lt * 72, 72, VT + 32 * vt * 72, 72, 4, lane);
        float hv[16];
#pragma unroll
        for (int i = 0; i < 16; ++i) { const int l = 32 * lt + crow(i, h); const float wi = fwi[l]; const float den = wi * fqn[l] + frs[l] + frs[64 + l];
            const float dn = fmaxf(fabsf(den), __expf(-fmt[l])); hv[i] = (wi * ae[i] + as_[i]) / dn;
            const float sq = red32_sum(hv[i] * hv[i]); if (r == 0) fss[vt * 64 + l] = sq; }
        __syncthreads();
        const int v = 32 * vt + r; const float gv = a.ng[hh * 128 + v];
#pragma unroll
        for (int i = 0; i < 16; ++i) { const int l = 32 * lt + crow(i, h); const float ss = fss[l] + fss[64 + l] + fss[128 + l] + fss[192 + l];
            const float rstd = rsqrtf(ss * (1.0f / 128.0f) + EPS); const size_t prow = (size_t)(t0 + l) * NPROJ;
            const float om = bf2f(a.P[prow + C_OM + hh * 128 + v]); a.P[prow + C_QM + hh * 128 + v] = f2bf(hv[i] * rstd * gv * sigmoidf_(om)); }
    }
    __syncthreads();
}
struct AtArgs { bf16* P; const float* KSUM; };
__device__ __forceinline__ void attn_unit(const AtArgs& a, LAS unsigned char* lds, int tid, int bh, int j) {
    const int lane = tid & 63, wave = tid >> 6, r = lane & 31, h = lane >> 5;
    const int b = bh >> 3, hh = bh & 7, q0 = b * SEQ + j * 256;
    LAS float* kmean = (LAS float*)lds;
    LAS unsigned* qmask = (LAS unsigned*)(kmean + 1024);
    LAS unsigned* anym = qmask + 256;
    LAS bf16* Kb = (LAS bf16*)(anym + 8);
    LAS bf16* Vb = Kb + 2 * 64 * 72;
    LAS bf16* Pw = Vb + 2 * 64 * 72 + wave * 32 * 72;
    for (int e = tid; e < 1024; e += 512) { const int n = e >> 6, d = e & 63; const float* ks = a.KSUM + ((size_t)bh * 64 + n * 4) * 64 + d; kmean[e] = (ks[0] + ks[64] + ks[128] + ks[192]) * (1.0f / 256.0f); }
    __syncthreads();
    if (tid < 256) {
        unsigned msk = 0u;
        if (j > 0) {
            float qv[64]; const bf16* qp = a.P + (size_t)(q0 + tid) * NPROJ + C_QA + hh * 64;
#pragma unroll
            for (int k = 0; k < 8; ++k) { const u32x4 w = *(const u32x4*)(qp + 8 * k); f32x4 x0, x1; unpack8(w, x0, x1);
#pragma unroll
                for (int e = 0; e < 4; ++e) { qv[8 * k + e] = x0[e]; qv[8 * k + 4 + e] = x1[e]; } }
            float v0 = -3e38f, v1 = -3e38f, v2 = -3e38f; int i0 = -1, i1 = -1, i2 = -1;
            for (int n = 0; n < j; ++n) { float g = 0.f;
#pragma unroll
                for (int d = 0; d < 64; ++d) g += qv[d] * kmean[n * 64 + d];
                if (g > v0) { v2 = v1; i2 = i1; v1 = v0; i1 = i0; v0 = g; i0 = n; } else if (g > v1) { v2 = v1; i2 = i1; v1 = g; i1 = n; } else if (g > v2) { v2 = g; i2 = n; } }
            if (i0 >= 0) msk |= 1u << i0; if (i1 >= 0) msk |= 1u << i1; if (i2 >= 0) msk |= 1u << i2;
        }
        qmask[tid] = msk;
        unsigned om = msk;
#pragma unroll
        for (int o = 1; o < 64; o <<= 1) om |= __shfl_xor(om, o);
        if (lane == 0) anym[wave] = om;
    }
    __syncthreads();
    const unsigned blkmask = (anym[0] | anym[1] | anym[2] | anym[3]) | (1u << j);
    const unsigned mymask = qmask[32 * wave + r];
    bf16x8 bq[4];
    { const bf16* qp = a.P + (size_t)(q0 + 32 * wave + r) * NPROJ + C_QA + hh * 64 + 8 * h;
#pragma unroll
      for (int ks = 0; ks < 4; ++ks) bq[ks] = *(const bf16x8*)(qp + 16 * ks); }
    f32x16 o0, o1; for (int i = 0; i < 16; ++i) { o0[i] = 0.f; o1[i] = 0.f; }
    float mrun = NEGF, lrun = 0.f;
    const int srow = tid >> 3, sch = (tid & 7) * 8;
    const bf16* kbase = a.P + (size_t)(b * SEQ) * NPROJ + C_KA + hh * 64 + sch;
    const bf16* vbase = a.P + (size_t)(b * SEQ) * NPROJ + C_VA + hh * 64 + sch;
    unsigned rem = blkmask; int n = __builtin_ctz(rem), t = 0; rem &= rem - 1;
    u32x4 kreg = *(const u32x4*)(kbase + (size_t)(n * 256 + t * 64 + srow) * NPROJ), vreg = *(const u32x4*)(vbase + (size_t)(n * 256 + t * 64 + srow) * NPROJ);
    int buf = 0;
    for (;;) {
        LAS bf16* Kc = Kb + buf * 64 * 72; LAS bf16* Vc = Vb + buf * 64 * 72;
        *(LAS u32x4*)(Kc + srow * 72 + sch) = kreg;
        { const unsigned vv[4] = {vreg.x, vreg.y, vreg.z, vreg.w};
#pragma unroll
          for (int e = 0; e < 4; ++e) { Vc[(sch + 2 * e) * 72 + srow] = (bf16)(vv[e] & 0xffffu); Vc[(sch + 2 * e + 1) * 72 + srow] = (bf16)(vv[e] >> 16); } }
        __syncthreads();
        const int cn = n, ct = t;
        bool more = true; if (t < 3) ++t; else if (rem) { n = __builtin_ctz(rem); rem &= rem - 1; t = 0; } else more = false;
        if (more) { kreg = *(const u32x4*)(kbase + (size_t)(n * 256 + t * 64 + srow) * NPROJ); vreg = *(const u32x4*)(vbase + (size_t)(n * 256 + t * 64 + srow) * NPROJ); }
        const bool own = (cn == j);
        const bool active = own ? (2 * ct <= wave) : true;
        if (active) {
            f32x16 s0, s1; for (int i = 0; i < 16; ++i) { s0[i] = 0.f; s1[i] = 0.f; }
            { const LAS bf16* kp0 = Kc + r * 72 + 8 * h; const LAS bf16* kp1 = kp0 + 32 * 72;
#pragma unroll
              for (int ks = 0; ks < 4; ++ks) { s0 = __builtin_amdgcn_mfma_f32_32x32x16_bf16(*(const LAS bf16x8*)(kp0 + 16 * ks), bq[ks], s0, 0, 0, 0);
                                               s1 = __builtin_amdgcn_mfma_f32_32x32x16_bf16(*(const LAS bf16x8*)(kp1 + 16 * ks), bq[ks], s1, 0, 0, 0); } }
            const bool sel = own ? true : (((mymask >> cn) & 1u) != 0u);
            if (own) { const int qrel = 32 * wave + r - 64 * ct;
#pragma unroll
                for (int i = 0; i < 16; ++i) { const int kk = crow(i, h); if (kk > qrel) s0[i] = NEGF; if (kk + 32 > qrel) s1[i] = NEGF; } }
            float tm = NEGF;
#pragma unroll
            for (int i = 0; i < 16; ++i) tm = fmaxf(tm, fmaxf(s0[i], s1[i]));
            tm = fmaxf(tm, __shfl_xor(tm, 32));
            const float mnew = sel ? fmaxf(mrun, tm) : mrun;
            const float alpha = exp2f(mrun - mnew);
            float ps = 0.f;
#pragma unroll
            for (int i = 0; i < 16; ++i) { const float p0 = sel ? exp2f(s0[i] - mnew) : 0.f, p1 = sel ? exp2f(s1[i] - mnew) : 0.f; s0[i] = p0; s1[i] = p1; ps += p0 + p1; }
            lrun = lrun * alpha + ps; mrun = mnew;
#pragma unroll
            for (int i = 0; i < 16; ++i) { o0[i] *= alpha; o1[i] *= alpha; }
#pragma unroll
            for (int g = 0; g < 4; ++g) { u32x2 w0, w1; w0.x = cvt_pk_bf16(s0[4 * g], s0[4 * g + 1]); w0.y = cvt_pk_bf16(s0[4 * g + 2], s0[4 * g + 3]); w1.x = cvt_pk_bf16(s1[4 * g], s1[4 * g + 1]); w1.y = cvt_pk_bf16(s1[4 * g + 2], s1[4 * g + 3]);
                *(LAS u32x2*)(Pw + r * 72 + 8 * g + 4 * h) = w0; *(LAS u32x2*)(Pw + r * 72 + 32 + 8 * g + 4 * h) = w1; }
            asm volatile("s_waitcnt lgkmcnt(0)" ::: "memory");
            o0 = mma32(o0, Vc, 72, Pw, 72, 4, lane);
            o1 = mma32(o1, Vc + 32 * 72, 72, Pw, 72, 4, lane);
        }
        if (!more) break;
        buf ^= 1;
    }
    lrun += __shfl_xor(lrun, 32);
    const float inv = 1.0f / lrun;
    __syncthreads();
    bf16* op = a.P + (size_t)(q0 + 32 * wave + r) * NPROJ + C_QA + hh * 64;
#pragma unroll
    for (int g = 0; g < 4; ++g) { u32x2 w0, w1; w0.x = cvt_pk_bf16(o0[4 * g] * inv, o0[4 * g + 1] * inv); w0.y = cvt_pk_bf16(o0[4 * g + 2] * inv, o0[4 * g + 3] * inv);
        w1.x = cvt_pk_bf16(o1[4 * g] * inv, o1[4 * g + 1] * inv); w1.y = cvt_pk_bf16(o1[4 * g + 2] * inv, o1[4 * g + 3] * inv);
        *(u32x2*)(op + 8 * g + 4 * h) = w0; *(u32x2*)(op + 32 + 8 * g + 4 * h) = w1; }
    __syncthreads();
}
__device__ __forceinline__ void p9_conv(const bf16* U, bf16* Gh, const float* cw, int tid, int G) {
    const int gt = blockIdx.x * 512 + tid, NT = G * 512;
    for (int it = gt; it < 256 * 352; it += NT) { const int ch = it / 352, cg8 = (it % 352) * 8; const int r0 = ch * 32; const bool first = (r0 & (SEQ - 1)) == 0;
        f32x4 wg[3][2], wu[3][2];
#pragma unroll
        for (int k = 0; k < 3; ++k) { wg[k][0] = *(const f32x4*)(cw + k * NUP + cg8); wg[k][1] = *(const f32x4*)(cw + k * NUP + cg8 + 4); wu[k][0] = *(const f32x4*)(cw + k * NUP + DFF + cg8); wu[k][1] = *(const f32x4*)(cw + k * NUP + DFF + cg8 + 4); }
        f32x4 g0[2], g1[2], u0[2], u1[2];
        if (first) { for (int e = 0; e < 2; ++e) { g0[e] = (f32x4){0.f, 0.f, 0.f, 0.f}; g1[e] = g0[e]; u0[e] = g0[e]; u1[e] = g0[e]; } }
        else { unpack8(*(const u32x4*)(U + (size_t)(r0 - 2) * NUP + cg8), g0[0], g0[1]); unpack8(*(const u32x4*)(U + (size_t)(r0 - 1) * NUP + cg8), g1[0], g1[1]);
               unpack8(*(const u32x4*)(U + (size_t)(r0 - 2) * NUP + DFF + cg8), u0[0], u0[1]); unpack8(*(const u32x4*)(U + (size_t)(r0 - 1) * NUP + DFF + cg8), u1[0], u1[1]); }
#pragma unroll 4
        for (int t = 0; t < 32; ++t) { f32x4 g2[2], u2[2]; unpack8(*(const u32x4*)(U + (size_t)(r0 + t) * NUP + cg8), g2[0], g2[1]); unpack8(*(const u32x4*)(U + (size_t)(r0 + t) * NUP + DFF + cg8), u2[0], u2[1]);
            f32x4 o[2];
#pragma unroll
            for (int e = 0; e < 2; ++e) { const f32x4 gg = wg[0][e] * g0[e] + wg[1][e] * g1[e] + wg[2][e] * g2[e]; const f32x4 uu = wu[0][e] * u0[e] + wu[1][e] * u1[e] + wu[2][e] * u2[e];
                o[e] = (f32x4){siluf_(gg[0]) * uu[0], siluf_(gg[1]) * uu[1], siluf_(gg[2]) * uu[2], siluf_(gg[3]) * uu[3]}; g0[e] = g1[e]; g1[e] = g2[e]; u0[e] = u1[e]; u1[e] = u2[e]; }
            *(u32x4*)(Gh + (size_t)(r0 + t) * DFF + cg8) = pack8(o[0], o[1]); }
    }
}
__device__ __forceinline__ void p11_final(float* out, const float* rss2, const float* gf, int tid, int G) {
    const int lane = tid & 63, wave = tid >> 6; const int gw = blockIdx.x * 8 + wave, NGW = G * 8;
    for (int m = gw; m < MT; m += NGW) { const float rstd = rsqrtf(rss2[m] * (1.0f / DM) + EPS); f32x4* xr = (f32x4*)(out + (size_t)m * DM) + lane;
#pragma unroll
        for (int jj = 0; jj < 4; ++jj) { const f32x4 g = *((const f32x4*)gf + lane + 64 * jj); xr[64 * jj] = xr[64 * jj] * rstd * g; } }
}

struct Args { const float* in[16]; float* out; unsigned char* ws; };
#define GSYNC() grid.sync()
#ifndef PROBE
#define PROBE 0
#endif
#ifndef PROBE_K
#define PROBE_K 1
#endif
#define PB(n) do { if (PROBE == (n)) pt0 = __builtin_amdgcn_s_memrealtime(); } while (0)
#define PE(n) do { if (PROBE == (n)) pdt += __builtin_amdgcn_s_memrealtime() - pt0; } while (0)
#define XB_TMO      128
#define XB_XCNT(j)  (256  + 64 * (j))
#define XB_XSUB(j)  (1280 + 64 * (j))
#define XB_XGEN(j)  (2304 + 64 * (j))
#define XB_TOP      3328
#define XB_TOPGEN   3392
#define XCD_BAR_WORDS 3456
#define XB_SPIN_CAP (1u << 18)

__device__ __forceinline__ unsigned xb_ld(unsigned* p)              { return __hip_atomic_load(p, __ATOMIC_RELAXED, __HIP_MEMORY_SCOPE_AGENT); }
__device__ __forceinline__ unsigned xb_add(unsigned* p, unsigned v) { return __hip_atomic_fetch_add(p, v, __ATOMIC_RELAXED, __HIP_MEMORY_SCOPE_AGENT); }
__device__ __forceinline__ unsigned xb_xcc_id() { return (unsigned)__builtin_amdgcn_s_getreg((3 << 11) | 20) & 0xFu; }
#define XB_SPIN(cond, bar) do { unsigned _sp = 0; while (cond) { __builtin_amdgcn_s_sleep(1); \
    if ((++_sp & 255u) == 0u) { if (xb_ld(&(bar)[XB_TMO])) break; if (_sp > XB_SPIN_CAP) { atomicAdd(&(bar)[XB_TMO], 1u); break; } } } } while (0)

struct XcdBarrier {
    unsigned* bar; unsigned x;
    volatile LAS unsigned* st;
};

__device__ __forceinline__ XcdBarrier xcd_barrier_post(unsigned* bar, volatile LAS unsigned* st) {
    XcdBarrier b; b.bar = bar; b.x = xb_xcc_id(); b.st = st;
    if (threadIdx.x == 0) (void)xb_add(&bar[XB_XCNT(b.x)], 1u);
    return b;
}
__device__ __forceinline__ void xcd_barrier_complete(unsigned* bar, unsigned x, unsigned& nloc, unsigned& nx) {
    const unsigned G = gridDim.x * gridDim.y * gridDim.z;
    unsigned sum, cnt, mine, sp = 0u;
    for (;;) {
        sum = 0u; cnt = 0u; mine = 0u;
#pragma unroll
        for (unsigned j = 0; j < 16; ++j) { const unsigned c = xb_ld(&bar[XB_XCNT(j)]); sum += c; cnt += (c > 0u) ? 1u : 0u; mine = (j == x) ? c : mine; }
        if (sum == G) break;
        __builtin_amdgcn_s_sleep(1);
        if ((++sp & 255u) == 0u) { if (xb_ld(&bar[XB_TMO])) break; if (sp > XB_SPIN_CAP) { atomicAdd(&bar[XB_TMO], 1u); break; } }
    }
    nloc = mine > 0u ? mine : 1u; nx = cnt > 0u ? cnt : 1u;
}

__device__ __forceinline__ void xcd_barrier(const XcdBarrier& b) {
    asm volatile("s_waitcnt vmcnt(0)" ::: "memory");
    __syncthreads();
    if (threadIdx.x == 0) {
        unsigned* bar = b.bar;
        __builtin_amdgcn_s_waitcnt(0);
        unsigned nloc = b.st[0], nx = b.st[1];
        if (nloc == 0u) { xcd_barrier_complete(bar, b.x, nloc, nx); b.st[0] = nloc; b.st[1] = nx; }
        const unsigned old = xb_add(&bar[XB_XSUB(b.x)], 1u);
        const unsigned gen = old / nloc;
        if (old + 1u == (gen + 1u) * nloc) {
            __builtin_amdgcn_fence(__ATOMIC_RELEASE, "agent");
            asm volatile("s_waitcnt vmcnt(0)" ::: "memory");
            const unsigned og = xb_add(&bar[XB_TOP], 1u);
            const unsigned tg = og / nx;
            if (og + 1u == (tg + 1u) * nx) xb_add(&bar[XB_TOPGEN], 1u);
            else XB_SPIN(xb_ld(&bar[XB_TOPGEN]) == tg, bar);
            __builtin_amdgcn_fence(__ATOMIC_ACQUIRE, "agent");
            xb_add(&bar[XB_XGEN(b.x)], 1u);
            asm volatile("s_waitcnt vmcnt(0)" ::: "memory");
        } else {
            XB_SPIN(xb_ld(&bar[XB_XGEN(b.x)]) == gen, bar);
            __builtin_amdgcn_fence(__ATOMIC_ACQUIRE, "agent");
            asm volatile("s_waitcnt vmcnt(0)" ::: "memory");
        }
    }
    __syncthreads();
}

__device__ __forceinline__ unsigned long long karg(int i) { const volatile unsigned long long* ka = (const volatile unsigned long long*)__builtin_amdgcn_kernarg_segment_ptr(); const unsigned long long v = ka[i]; const unsigned lo = __builtin_amdgcn_readfirstlane((unsigned)v), hi = __builtin_amdgcn_readfirstlane((unsigned)(v >> 32)); return ((unsigned long long)hi << 32) | lo; }
#define KIN(i) ((const float*)karg(i))
#define KOUT() ((float*)karg(16))
#define KWS(off) ((unsigned char*)karg(17) + (off))
__global__ void __launch_bounds__(512) fwd_mega(Args args) {
    extern __shared__ __attribute__((aligned(16))) unsigned char lds_raw[];
    cg::grid_group grid = cg::this_grid();
    LAS unsigned char* lds = (LAS unsigned char*)lds_raw;
    const int tid = threadIdx.x, G = gridDim.x;
    unsigned long long pt0 = 0, pdt = 0;
    if (tid < 2) ((volatile LAS unsigned*)(lds + 131072 + 512))[tid] = 0u;
    if (blockIdx.x == 0) { unsigned* bw = (unsigned*)KWS(WS_BAR); for (int i = tid; i < XCD_BAR_WORDS; i += 512) bw[i] = 0u; }
    PB(1);
    { P0Args a{KIN(0), KIN(2), KIN(3), KIN(8), KIN(9), KIN(10), KIN(11), KIN(12), KIN(14), (bf16*)KWS(WS_WIN), (bf16*)KWS(WS_WBA), (bf16*)KWS(WS_WBM), (bf16*)KWS(WS_WO), (bf16*)KWS(WS_WUP), (bf16*)KWS(WS_WDN), (bf16*)KWS(WS_H), (float*)KWS(WS_RSS1), (float*)KWS(WS_RSS2)};
      p0_prologue(a, lds, tid, G); }
    GSYNC();
    XcdBarrier xbar = xcd_barrier_post((unsigned*)KWS(WS_BAR), (volatile LAS unsigned*)(lds + 131072 + 512));
    PE(1);
    PB(2);
    { pg8::Gemm g{(const bf16*)KWS(WS_H), (const bf16*)KWS(WS_WIN), MT, NPROJ_PAD, DM, DM, DM}; pg8::StaticOrder S; S.init(MT, NPROJ_PAD, G, (int)blockIdx.x); EpiProj E{(bf16*)KWS(WS_PROJ)};
      pg8::gemm_phase<EpiProj, pg8::StaticOrder, true, true>(lds, g, S, E); }
    xcd_barrier(xbar);
    PE(2);
    PB(3);
    { P2Args a{(bf16*)KWS(WS_PROJ), (const int*)karg(1), KIN(4), KIN(5), KIN(6), (bf16*)KWS(WS_QM), (bf16*)KWS(WS_KM), (float*)KWS(WS_GA), (float*)KWS(WS_GB), (float*)KWS(WS_ST), (float*)KWS(WS_KSUM)};
      for (int u = blockIdx.x; u < 256; u += G) p2_unit(a, lds, tid, u); }
    xcd_barrier(xbar);
    PE(3);
    PB(4);
    { P3Args a{(const bf16*)KWS(WS_PROJ), (const bf16*)KWS(WS_KM), (const float*)KWS(WS_GA), (const float*)KWS(WS_GB), (const float*)KWS(WS_ST), KOUT(), (float*)KWS(WS_NL), (float*)KWS(WS_MC), (float*)KWS(WS_CSC)};
      for (int u = blockIdx.x; u < 1024; u += G) p3_unit(a, lds, tid, u); }
    PE(4);
    PB(5);
    { AtArgs at{(bf16*)KWS(WS_PROJ), (const float*)KWS(WS_KSUM)};
      for (int p = blockIdx.x; p < 256; p += G) { const int bh = p >> 3, jj = p & 7; attn_unit(at, lds, tid, bh, jj); attn_unit(at, lds, tid, bh, 15 - jj); } }
    xcd_barrier(xbar);
    PE(5);
    PB(6);
    p4_scan(KOUT(), (float*)KWS(WS_NL), (const float*)KWS(WS_CSC), tid, G);
    xcd_barrier(xbar);
    PE(6);
    PB(7);
    { P5Args a{(bf16*)KWS(WS_PROJ), (const bf16*)KWS(WS_QM), (const bf16*)KWS(WS_KM), (const float*)KWS(WS_GA), (const float*)KWS(WS_GB), KOUT(), (const float*)KWS(WS_NL), (const float*)KWS(WS_MC), KIN(7)};
      for (int u = blockIdx.x; u < 1024; u += G) p5_unit(a, lds, tid, u); }
    xcd_barrier(xbar);
    PE(7);
    PB(8);
    { pg8::Gemm g{(const bf16*)KWS(WS_PROJ) + C_QA, (const bf16*)KWS(WS_WBA), MT, DM, 512, NPROJ, 512}; pg8::StaticOrder S; S.init(MT, DM, G, (int)blockIdx.x); EpiGate<false> E{(const bf16*)KWS(WS_PROJ), (bf16*)KWS(WS_MRG), C_GA};
      pg8::gemm_phase<EpiGate<false>, pg8::StaticOrder, true, true>(lds, g, S, E); }
    __syncthreads();
    { pg8::Gemm g{(const bf16*)KWS(WS_PROJ) + C_QM, (const bf16*)KWS(WS_WBM), MT, DM, 512, NPROJ, 512}; pg8::StaticOrder S; S.init(MT, DM, G, (int)blockIdx.x); EpiGate<true> E{(const bf16*)KWS(WS_PROJ), (bf16*)KWS(WS_MRG), C_GM};
      pg8::gemm_phase<EpiGate<true>, pg8::StaticOrder, true, true>(lds, g, S, E); }
    xcd_barrier(xbar);
    PE(8);
    PB(9);
    { pg8::Gemm g{(const bf16*)KWS(WS_MRG), (const bf16*)KWS(WS_WO), MT, DM, DM, DM, DM}; pg8::StaticOrder S; S.init(MT, DM, G, (int)blockIdx.x); EpiRes1 E{KIN(0), KOUT(), (bf16*)KWS(WS_X1B), (float*)KWS(WS_RSS1)};
      pg8::gemm_phase<EpiRes1, pg8::StaticOrder, true, true>(lds, g, S, E); }
    xcd_barrier(xbar);
    PE(9);
    for (int hf = 0; hf < 2; ++hf) {
        PB(10);
        { pg8::Gemm g{(const bf16*)KWS(WS_X1B) + (size_t)hf * 8192 * DM, (const bf16*)KWS(WS_WUP), 8192, NUP, DM, DM, DM}; pg8::StaticOrder S; S.init(8192, NUP, G, (int)blockIdx.x); EpiUp E{(bf16*)KWS(WS_U), (const float*)KWS(WS_RSS1) + hf * 8192};
          pg8::gemm_phase<EpiUp, pg8::StaticOrder, true, true>(lds, g, S, E); }
        xcd_barrier(xbar);
        PE(10);
        PB(11);
        p9_conv((const bf16*)KWS(WS_U), (bf16*)KWS(WS_G) + (size_t)hf * 8192 * DFF, KIN(13), tid, G);
        xcd_barrier(xbar);
        PE(11);
    }
    PB(12);
    { pg8::Gemm g{(const bf16*)KWS(WS_G), (const bf16*)KWS(WS_WDN), MT, DM, DFF, DFF, DFF}; pg8::StaticOrder S; S.init(MT, DM, G, (int)blockIdx.x); EpiRes2 E{KOUT(), (float*)KWS(WS_RSS2)};
      pg8::gemm_phase<EpiRes2, pg8::StaticOrder, true, true>(lds, g, S, E); }
    xcd_barrier(xbar);
    PE(12);
    PB(13);
    p11_final(KOUT(), (const float*)KWS(WS_RSS2), KIN(15), tid, G);
    PE(13);
    if (PROBE == 15) { PB(15); for (int k = 0; k < 8; ++k) xcd_barrier(xbar); PE(15); }
    if (PROBE != 0) { const unsigned long long te = __builtin_amdgcn_s_memrealtime(); while (__builtin_amdgcn_s_memrealtime() - te < pdt * PROBE_K) __builtin_amdgcn_s_sleep(8); }
}

extern "C" void kernel_launch(void* const* d_in, const int* in_sizes, int n_in, void* d_out, int out_size, void* d_ws, size_t ws_size, hipStream_t stream) {
    static int grid = 0;
    if (grid == 0) {
        if (n_in != 16 || out_size != MT * DM || ws_size < WS_END) { fprintf(stderr, "kernel_launch: unexpected shapes n_in %d out %d ws %zu\n", n_in, out_size, ws_size); grid = -1; return; }
        int dev = 0, cus = 0, per = 0;
        (void)hipGetDevice(&dev); (void)hipDeviceGetAttribute(&cus, hipDeviceAttributeMultiprocessorCount, dev);
        (void)hipFuncSetAttribute((const void*)fwd_mega, hipFuncAttributeMaxDynamicSharedMemorySize, LDS_BYTES);
        (void)hipOccupancyMaxActiveBlocksPerMultiprocessor(&per, (const void*)fwd_mega, 512, LDS_BYTES);
        if (per < 1) per = 1;
        grid = cus * per;
        fprintf(stderr, "kernel_launch: grid %d (cus %d x %d)\n", grid, cus, per);
    }
    if (grid < 0) return;
    Args a{};
    for (int i = 0; i < 16; ++i) a.in[i] = (const float*)d_in[i];
    a.out = (float*)d_out; a.ws = (unsigned char*)d_ws;
    void* kargs[] = {&a};
    hipError_t e = hipLaunchCooperativeKernel((const void*)fwd_mega, dim3(grid), dim3(512), kargs, LDS_BYTES, stream);
    if (e != hipSuccess) fprintf(stderr, "kernel_launch: cooperative launch failed: %s (grid %d)\n", hipGetErrorString(e), grid);
}
```

```cpp
#include <hip/hip_runtime.h>
#include <hip/hip_cooperative_groups.h>
#include <cstdio>
#include <cstdint>
namespace cg = cooperative_groups;
namespace pg8 {
#define PG8_LAS __attribute__((address_space(3)))
typedef unsigned short bf16_t;
typedef short bf16x8 __attribute__((ext_vector_type(8)));
typedef float f32x4 __attribute__((ext_vector_type(4)));
typedef unsigned u32x4 __attribute__((ext_vector_type(4)));
constexpr int BM = 256, BK = 64, HALF = 128, HTB = HALF * BK * 2  , STAGE_BYTES = 8 * HTB, NXCD = 8, WGM = 8;

__host__ __device__ __forceinline__ int lds_byte(int r, int c) { const int st = (r >> 4) * 2 + (c >> 5), rr = r & 15, cc = c & 31, ob = rr * 64 + cc * 2; return st * 1024 + (ob ^ (((ob >> 9) & 1) << 5)); }
__host__ __device__ __forceinline__ void stage_rc(int b, int& R, int& C) { const int st = b / 1024, sb = b % 1024, swz = sb ^ (((sb >> 9) & 1) << 5); R = (st >> 1) * 16 + swz / 64; C = (st & 1) * 32 + (swz % 64) / 2; }
__host__ __device__ __forceinline__ int perm32(int rho) { const int n = rho >> 4, i = rho & 15; return 8 * (i >> 2) + 4 * n + (i & 3); }

struct Unit { int pm, pn; };
struct Gemm { const bf16_t* A; const bf16_t* Bt; int M, N, K, lda, ldb; };

struct StaticOrder {
    int nM, nN, nwg, G, c;
    __host__ __device__ void init(int M, int N, int G_, int c_) { nM = M / BM; nN = N / BM; nwg = nM * nN; G = G_; c = c_; }
    __host__ __device__ bool next(int i, Unit& u) const {
        const long L = (long)i * G + c; if (L >= nwg) return false;
        int wgid = (int)L; { const int q = nwg / NXCD, r = nwg % NXCD, xcd = wgid % NXCD, off = wgid / NXCD; wgid = (xcd < r ? xcd * (q + 1) : r * (q + 1) + (xcd - r) * q) + off; }
        const int nig = WGM * nN, gid = wgid / nig, fm = gid * WGM, gsz = (nM - fm) < WGM ? (nM - fm) : WGM;
        u.pm = fm + ((wgid % nig) % gsz); u.pn = (wgid % nig) / gsz; return true;
    }
    __device__ __forceinline__ void a_ready(const Unit&) const {}
    __device__ __forceinline__ void done(const Unit&) const {}
};

__device__ __forceinline__ unsigned cvt_pk_bf16(float lo, float hi) { unsigned r; asm volatile("v_cvt_pk_bf16_f32 %0, %1, %2" : "=v"(r) : "v"(lo), "v"(hi)); return r; }
template <class Epi, class Sched, bool ALIGN_EPI = false, bool SP2 = false>
__device__ __forceinline__ void gemm_phase(PG8_LAS unsigned char* lds, const Gemm g, const Sched& S, const Epi& E) {
    const int tid = threadIdx.x, wid = __builtin_amdgcn_readfirstlane(tid >> 6), lane = tid & 63, wr = wid >> 2, wc = wid & 3, fr = lane & 15, fq = lane >> 4;
    const int K = g.K, nt = K / BK;
    unsigned voffA[2], voffB[2];
#pragma unroll
    for (int i = 0; i < 2; ++i) { int R, C; stage_rc(tid * 16 + i * 8192, R, C); const int Rb = Epi::PERM ? ((R & ~31) + perm32(R & 31)) : R;
        voffA[i] = (unsigned)(R * g.lda + C) * 2u; voffB[i] = (unsigned)(Rb * g.ldb + C) * 2u; }
    const size_t kstep = (size_t)(BK * 2);
    const size_t hstepA = (size_t)HALF * g.lda * 2, hstepB = (size_t)HALF * g.ldb * 2;
    const size_t tstepA = 2 * hstepA, tstepB = 2 * hstepB;
    const unsigned ldsw = (unsigned)wid * 1024u;
    const int aoff = lds_byte(wr * 64 + fr, fq * 8), boff = lds_byte(wc * 32 + fr, fq * 8);
#define PG8_SA(b, h) (((b) * 2 + (h)) * HTB)
#define PG8_SB(b, h) ((4 + (b) * 2 + (h)) * HTB)
#define PG8_STAGE(bufoff, gbase, voff) do { _Pragma("unroll") for (int _i = 0; _i < 2; ++_i) \
        __builtin_amdgcn_global_load_lds((const unsigned*)((const char*)(gbase) + (voff)[_i]), (PG8_LAS unsigned*)(lds + (bufoff) + ldsw + _i * 8192), 16, 0, 0); } while (0)
#define PG8_LDA(dst, b, h) do { _Pragma("unroll") for (int m = 0; m < 4; ++m) _Pragma("unroll") for (int k = 0; k < 2; ++k) dst[m][k] = *(const PG8_LAS bf16x8*)(lds + PG8_SA(b, h) + aoff + m * 2048 + k * 1024); } while (0)
#define PG8_LDB(dst, b, h) do { _Pragma("unroll") for (int n = 0; n < 2; ++n) _Pragma("unroll") for (int k = 0; k < 2; ++k) dst[n][k] = *(const PG8_LAS bf16x8*)(lds + PG8_SB(b, h) + boff + n * 2048 + k * 1024); } while (0)
#define PG8_MMA(ai, bj, At, Bt) do { __builtin_amdgcn_s_setprio(1); _Pragma("unroll") for (int m = 0; m < 4; ++m) _Pragma("unroll") for (int n = 0; n < 2; ++n) _Pragma("unroll") for (int k = 0; k < 2; ++k) \
        acc[ai][bj][m][n] = __builtin_amdgcn_mfma_f32_16x16x32_bf16(Bt[n][k], At[m][k], acc[ai][bj][m][n], 0, 0, 0); __builtin_amdgcn_s_setprio(0); } while (0)
#define PG8_WAIT_V(n) asm volatile("s_waitcnt vmcnt(" #n ")" ::: "memory")
#define PG8_WAIT_L(n) asm volatile("s_waitcnt lgkmcnt(" #n ")" ::: "memory")
#define PG8_BAR __builtin_amdgcn_s_barrier()
#define PG8_SCHED __builtin_amdgcn_sched_barrier(0)
    Unit cur, nxt; int ui = 0;
    if (!S.next(0, cur)) return;
    f32x4 acc[2][2][4][2];
#pragma unroll
    for (int a = 0; a < 2; ++a)
#pragma unroll
        for (int b = 0; b < 2; ++b)
#pragma unroll
            for (int m = 0; m < 4; ++m)
#pragma unroll
                for (int n = 0; n < 2; ++n) acc[a][b][m][n] = (f32x4){0.f, 0.f, 0.f, 0.f};
    bf16x8 At[4][2], B0[2][2], B1[2][2];
    const char* cA = (const char*)g.A + (size_t)cur.pm * tstepA; const char* cB = (const char*)g.Bt + (size_t)cur.pn * tstepB;
    S.a_ready(cur);
    if constexpr (SP2) {
        PG8_STAGE(PG8_SB(0, 0), cB, voffB); PG8_STAGE(PG8_SB(0, 1), cB + hstepB, voffB); PG8_STAGE(PG8_SA(0, 0), cA, voffA); PG8_STAGE(PG8_SA(0, 1), cA + hstepA, voffA);
        if (wr == 1) PG8_BAR;
        PG8_WAIT_V(2); PG8_BAR;
        PG8_STAGE(PG8_SB(1, 0), cB + kstep, voffB); PG8_STAGE(PG8_SA(1, 0), cA + kstep, voffA); PG8_STAGE(PG8_SB(1, 1), cB + hstepB + kstep, voffB);
        PG8_WAIT_V(6); PG8_BAR;
    } else {
        PG8_STAGE(PG8_SB(0, 0), cB, voffB); PG8_STAGE(PG8_SA(0, 0), cA, voffA); PG8_STAGE(PG8_SB(0, 1), cB + hstepB, voffB); PG8_STAGE(PG8_SA(0, 1), cA + hstepA, voffA);
        if (wr == 1) PG8_BAR;
        PG8_WAIT_V(4); PG8_BAR;
        PG8_STAGE(PG8_SB(1, 0), cB + kstep, voffB); PG8_STAGE(PG8_SA(1, 0), cA + kstep, voffA); PG8_STAGE(PG8_SB(1, 1), cB + hstepB + kstep, voffB);
        PG8_WAIT_V(6); PG8_BAR;
    }
    for (;;) {
        const bool has_next = S.next(ui + 1, nxt);
        const char* nA = has_next ? (const char*)g.A + (size_t)nxt.pm * tstepA : cA; const char* nB = has_next ? (const char*)g.Bt + (size_t)nxt.pn * tstepB : cB;
        for (int t = 0; t < nt; t += 2) {
            const bool last = (t == nt - 2);
            const char* a1 = cA + (size_t)(t + 1) * kstep;
            const char* a2 = last ? nA : cA + (size_t)(t + 2) * kstep; const char* b2 = last ? nB : cB + (size_t)(t + 2) * kstep;
            const char* a3 = a2 + kstep; const char* b3 = b2 + kstep;
            if (last && has_next) S.a_ready(nxt);
            if constexpr (SP2) {
            PG8_LDB(B0, 0, 0); PG8_LDB(B1, 0, 1); PG8_SCHED; PG8_LDA(At, 0, 0); PG8_STAGE(PG8_SA(1, 1), a1 + hstepA, voffA);
            PG8_WAIT_V(8); PG8_WAIT_L(0); PG8_BAR; PG8_MMA(0, 0, At, B0); PG8_MMA(0, 1, At, B1); PG8_BAR; PG8_SCHED;
            PG8_LDA(At, 0, 1); PG8_STAGE(PG8_SB(0, 0), b2, voffB); PG8_STAGE(PG8_SB(0, 1), b2 + hstepB, voffB); PG8_STAGE(PG8_SA(0, 0), a2, voffA);
            PG8_WAIT_V(8); PG8_WAIT_L(0); PG8_BAR; PG8_MMA(1, 0, At, B0); PG8_MMA(1, 1, At, B1); PG8_BAR; PG8_SCHED;
            PG8_LDB(B0, 1, 0); PG8_LDB(B1, 1, 1); PG8_SCHED; PG8_LDA(At, 1, 0); PG8_STAGE(PG8_SA(0, 1), a2 + hstepA, voffA);
            PG8_WAIT_V(8); PG8_WAIT_L(0); PG8_BAR; PG8_MMA(0, 0, At, B0); PG8_MMA(0, 1, At, B1); PG8_BAR; PG8_SCHED;
            PG8_LDA(At, 1, 1); PG8_STAGE(PG8_SB(1, 0), b3, voffB); PG8_STAGE(PG8_SB(1, 1), b3 + hstepB, voffB); PG8_STAGE(PG8_SA(1, 0), a3, voffA);
            PG8_WAIT_V(8); PG8_WAIT_L(0); PG8_BAR; PG8_MMA(1, 0, At, B0); PG8_MMA(1, 1, At, B1); PG8_BAR; PG8_SCHED;
            } else {
            PG8_LDB(B0, 0, 0); PG8_SCHED; PG8_LDA(At, 0, 0); PG8_STAGE(PG8_SA(1, 1), a1 + hstepA, voffA);
            PG8_WAIT_L(8); PG8_BAR; PG8_WAIT_L(0); PG8_MMA(0, 0, At, B0); PG8_BAR; PG8_SCHED;
            PG8_LDB(B1, 0, 1); PG8_STAGE(PG8_SB(0, 0), b2, voffB);
            PG8_BAR; PG8_WAIT_L(0); PG8_MMA(0, 1, At, B1); PG8_BAR;
            PG8_LDA(At, 0, 1); PG8_STAGE(PG8_SA(0, 0), a2, voffA);
            PG8_BAR; PG8_WAIT_L(0); PG8_MMA(1, 0, At, B0); PG8_BAR; PG8_SCHED;
            PG8_STAGE(PG8_SB(0, 1), b2 + hstepB, voffB);
            PG8_WAIT_V(6); PG8_BAR; PG8_MMA(1, 1, At, B1); PG8_BAR;
            PG8_LDB(B0, 1, 0); PG8_SCHED; PG8_LDA(At, 1, 0); PG8_STAGE(PG8_SA(0, 1), a2 + hstepA, voffA);
            PG8_WAIT_L(8); PG8_BAR; PG8_WAIT_L(0); PG8_MMA(0, 0, At, B0); PG8_BAR; PG8_SCHED;
            PG8_LDB(B1, 1, 1); PG8_STAGE(PG8_SB(1, 0), b3, voffB);
            PG8_BAR; PG8_WAIT_L(0); PG8_MMA(0, 1, At, B1); PG8_BAR;
            PG8_LDA(At, 1, 1); PG8_STAGE(PG8_SA(1, 0), a3, voffA);
            PG8_BAR; PG8_WAIT_L(0); PG8_MMA(1, 0, At, B0); PG8_BAR; PG8_SCHED;
            PG8_STAGE(PG8_SB(1, 1), b3 + hstepB, voffB);
            PG8_WAIT_V(6); PG8_BAR; PG8_MMA(1, 1, At, B1); PG8_BAR;
            }
        }
        if constexpr (ALIGN_EPI) { if (wr == 0) PG8_BAR; }
        if constexpr (!Epi::AFTER_DRAIN) { E(acc, cur, wr, wc, fr, fq); S.done(cur); }
        if (!has_next) break;
#pragma unroll
        for (int a = 0; a < 2; ++a)
#pragma unroll
            for (int b = 0; b < 2; ++b)
#pragma unroll
                for (int m = 0; m < 4; ++m)
#pragma unroll
                    for (int n = 0; n < 2; ++n) acc[a][b][m][n] = (f32x4){0.f, 0.f, 0.f, 0.f};
        cur = nxt; cA = nA; cB = nB; ++ui;
        if constexpr (ALIGN_EPI) { if (wr == 1) PG8_BAR; }
    }
    PG8_WAIT_V(0);
    if constexpr (!ALIGN_EPI) { if (wr == 0) PG8_BAR; }
    PG8_BAR;
    if constexpr (Epi::AFTER_DRAIN) { E.fused(acc, cur, wr, wc, fr, fq, lds, wid, lane); S.done(cur); }
#undef PG8_SA
#undef PG8_SB
#undef PG8_STAGE
#undef PG8_LDA
#undef PG8_LDB
#undef PG8_MMA
#undef PG8_WAIT_V
#undef PG8_WAIT_L
#undef PG8_BAR
#undef PG8_SCHED
}
}

#define LAS __attribute__((address_space(3)))
typedef unsigned short bf16;
typedef short bf16x8 __attribute__((ext_vector_type(8)));
typedef float f32x4 __attribute__((ext_vector_type(4)));
typedef float f32x16 __attribute__((ext_vector_type(16)));
typedef unsigned u32x4 __attribute__((ext_vector_type(4)));
typedef unsigned u32x2 __attribute__((ext_vector_type(2)));
constexpr int NB = 4, SEQ = 4096, DM = 1024, MT = NB * SEQ;
constexpr int NPROJ = 5640, NPROJ_PAD = 5888, DFF = 2816, NUP = 5632;
constexpr int C_QA = 0, C_KA = 512, C_VA = 1024, C_QM = 1536, C_KM = 2048, C_VM = 2560, C_OM = 3072, C_GA = 3584, C_GM = 4608, C_I = 5632, C_F = 5636;
constexpr float EPS = 1e-6f;
constexpr float QSCALE = 0.125f * 1.4426950408889634f;
constexpr float NEGF = -1e30f;
constexpr size_t MiB = 1u << 20;
constexpr size_t WS_RSS1 = 0, WS_RSS2 = 64 * 1024, WS_GA = 128 * 1024, WS_GB = 384 * 1024, WS_ST = 640 * 1024, WS_MC = 648 * 1024, WS_CSC = 652 * 1024,
                 WS_KSUM = 1 * MiB, WS_NL = 2 * MiB, WS_BAR = 3 * MiB;
constexpr size_t WS_WIN = 4 * MiB, WS_WUP = WS_WIN + 23 * MiB / 2, WS_WDN = WS_WUP + 11 * MiB, WS_WO = 32 * MiB, WS_WBA = 34 * MiB, WS_WBM = 35 * MiB;
constexpr size_t WS_H = 36 * MiB;
constexpr size_t WS_QM = WS_H, WS_KM = WS_H + 16 * MiB, WS_MRG = WS_H, WS_U = WS_H;
constexpr size_t WS_PROJ = 68 * MiB;
constexpr size_t WS_G = 124 * MiB;
constexpr size_t WS_X1B = 224 * MiB;
constexpr size_t WS_END = 256 * MiB;
constexpr int LDS_BYTES = 147456;

__device__ __forceinline__ float bf2f(unsigned short v) { return __uint_as_float((unsigned)v << 16); }
__device__ __forceinline__ unsigned short f2bf(float f) { unsigned u = __float_as_uint(f); return (unsigned short)((u + 0x7fffu + ((u >> 16) & 1u)) >> 16); }
__device__ __forceinline__ unsigned pk2(float lo, float hi) { return (unsigned)f2bf(lo) | ((unsigned)f2bf(hi) << 16); }
__device__ __forceinline__ float bflo(unsigned w) { return __uint_as_float(w << 16); }
__device__ __forceinline__ float bfhi(unsigned w) { return __uint_as_float(w & 0xffff0000u); }
__device__ __forceinline__ float sigmoidf_(float v) { return 1.0f / (1.0f + __expf(-v)); }
__device__ __forceinline__ float siluf_(float v) { return v / (1.0f + __expf(-v)); }
__device__ __forceinline__ float red32_sum(float v) { v += __shfl_xor(v, 1); v += __shfl_xor(v, 2); v += __shfl_xor(v, 4); v += __shfl_xor(v, 8); v += __shfl_xor(v, 16); return v; }
__device__ __forceinline__ float wave_sum(float v) {
#pragma unroll
    for (int o = 1; o < 64; o <<= 1) v += __shfl_xor(v, o);
    return v;
}
__device__ __forceinline__ float wave_max(float v) {
#pragma unroll
    for (int o = 1; o < 64; o <<= 1) v = fmaxf(v, __shfl_xor(v, o));
    return v;
}
__device__ __forceinline__ f32x16 mma32(f32x16 acc, const LAS bf16* A, int lda, const LAS bf16* B, int ldb, int ksteps, int lane) {
    const int r = lane & 31, h = lane >> 5;
    const LAS bf16* ap = A + r * lda + 8 * h; const LAS bf16* bp = B + r * ldb + 8 * h;
    for (int ks = 0; ks < ksteps; ++ks) {
        const bf16x8 a = *(const LAS bf16x8*)(ap + 16 * ks), b = *(const LAS bf16x8*)(bp + 16 * ks);
        acc = __builtin_amdgcn_mfma_f32_32x32x16_bf16(a, b, acc, 0, 0, 0);
    }
    return acc;
}
__device__ __forceinline__ int crow(int i, int h) { return (i & 3) + 8 * (i >> 2) + 4 * h; }
using pg8::Unit; using pg8::cvt_pk_bf16;
typedef const f32x4 (&AccRef)[2][2][4][2];
__device__ __forceinline__ u32x4 pack8(f32x4 a, f32x4 b) { u32x4 w; w.x = cvt_pk_bf16(a[0], a[1]); w.y = cvt_pk_bf16(a[2], a[3]); w.z = cvt_pk_bf16(b[0], b[1]); w.w = cvt_pk_bf16(b[2], b[3]); return w; }
__device__ __forceinline__ void unpack8(u32x4 w, f32x4& a, f32x4& b) { a = (f32x4){bflo(w.x), bfhi(w.x), bflo(w.y), bfhi(w.y)}; b = (f32x4){bflo(w.z), bfhi(w.z), bflo(w.w), bfhi(w.w)}; }
__device__ __forceinline__ f32x4 sig4(f32x4 v) { return (f32x4){sigmoidf_(v[0]), sigmoidf_(v[1]), sigmoidf_(v[2]), sigmoidf_(v[3])}; }
#define EPI_LOOP_BEGIN  _Pragma("unroll") for (int ai = 0; ai < 2; ++ai) _Pragma("unroll") for (int m = 0; m < 4; ++m) { const int row = u.pm * 256 + ai * 128 + wr * 64 + m * 16 + fr;
#define EPI_COL(bj) (u.pn * 256 + (bj) * 128 + wc * 32 + 8 * fq)
struct EpiProj { static constexpr bool PERM = true, AFTER_DRAIN = false; bf16* O;
    __device__ __forceinline__ void operator()(AccRef acc, const Unit& u, int wr, int wc, int fr, int fq) const {
        EPI_LOOP_BEGIN
#pragma unroll
            for (int bj = 0; bj < 2; ++bj) { const int col = EPI_COL(bj); if (col < NPROJ) *(u32x4*)(O + (size_t)row * NPROJ + col) = pack8(acc[ai][bj][m][0], acc[ai][bj][m][1]); }
        }
    }
};
template <bool ADD> struct EpiGate { static constexpr bool PERM = true, AFTER_DRAIN = false; const bf16* P; bf16* T; int gcol0;
    __device__ __forceinline__ void operator()(AccRef acc, const Unit& u, int wr, int wc, int fr, int fq) const {
        EPI_LOOP_BEGIN
#pragma unroll
            for (int bj = 0; bj < 2; ++bj) { const int col = EPI_COL(bj);
                const u32x4 gw = *(const u32x4*)(P + (size_t)row * NPROJ + gcol0 + col); f32x4 g0, g1; unpack8(gw, g0, g1);
                f32x4 v0 = acc[ai][bj][m][0] * sig4(g0), v1 = acc[ai][bj][m][1] * sig4(g1);
                bf16* tp = T + (size_t)row * DM + col;
                if (ADD) { f32x4 t0, t1; unpack8(*(const u32x4*)tp, t0, t1); v0 += t0; v1 += t1; }
                *(u32x4*)tp = pack8(v0, v1); }
        }
    }
};
struct EpiRes1 { static constexpr bool PERM = true, AFTER_DRAIN = false; const float* x; float* x1; bf16* x1b; float* rss;
    __device__ __forceinline__ void operator()(AccRef acc, const Unit& u, int wr, int wc, int fr, int fq) const {
        EPI_LOOP_BEGIN
            float ss = 0.f;
#pragma unroll
            for (int bj = 0; bj < 2; ++bj) { const int col = EPI_COL(bj); const size_t off = (size_t)row * DM + col;
                const f32x4 v0 = acc[ai][bj][m][0] + *(const f32x4*)(x + off), v1 = acc[ai][bj][m][1] + *(const f32x4*)(x + off + 4);
                *(f32x4*)(x1 + off) = v0; *(f32x4*)(x1 + off + 4) = v1; *(u32x4*)(x1b + off) = pack8(v0, v1);
                ss += (v0[0] * v0[0] + v0[1] * v0[1]) + (v0[2] * v0[2] + v0[3] * v0[3]) + (v1[0] * v1[0] + v1[1] * v1[1]) + (v1[2] * v1[2] + v1[3] * v1[3]); }
            ss += __shfl_xor(ss, 16); ss += __shfl_xor(ss, 32);
            if (fq == 0) unsafeAtomicAdd(rss + row, ss);
        }
    }
};
struct EpiUp { static constexpr bool PERM = true, AFTER_DRAIN = false; bf16* U; const float* rss;
    __device__ __forceinline__ void operator()(AccRef acc, const Unit& u, int wr, int wc, int fr, int fq) const {
        EPI_LOOP_BEGIN
            const float rs = rsqrtf(rss[row] * (1.0f / DM) + EPS);
#pragma unroll
            for (int bj = 0; bj < 2; ++bj) { const int col = EPI_COL(bj); *(u32x4*)(U + (size_t)row * NUP + col) = pack8(acc[ai][bj][m][0] * rs, acc[ai][bj][m][1] * rs); }
        }
    }
};
struct EpiRes2 { static constexpr bool PERM = true, AFTER_DRAIN = false; float* xio; float* rss;
    __device__ __forceinline__ void operator()(AccRef acc, const Unit& u, int wr, int wc, int fr, int fq) const {
        EPI_LOOP_BEGIN
            float ss = 0.f;
#pragma unroll
            for (int bj = 0; bj < 2; ++bj) { const int col = EPI_COL(bj); const size_t off = (size_t)row * DM + col;
                const f32x4 v0 = acc[ai][bj][m][0] + *(const f32x4*)(xio + off), v1 = acc[ai][bj][m][1] + *(const f32x4*)(xio + off + 4);
                *(f32x4*)(xio + off) = v0; *(f32x4*)(xio + off + 4) = v1;
                ss += (v0[0] * v0[0] + v0[1] * v0[1]) + (v0[2] * v0[2] + v0[3] * v0[3]) + (v1[0] * v1[0] + v1[1] * v1[1]) + (v1[2] * v1[2] + v1[3] * v1[3]); }
            ss += __shfl_xor(ss, 16); ss += __shfl_xor(ss, 32);
            if (fq == 0) unsafeAtomicAdd(rss + row, ss);
        }
    }
};
template <int MODE> __device__ __forceinline__ void transpose_item(const float* W, int K, int N, bf16* WT, LAS float* scr, int item, int lane, const float* gk) {
    const int nblk = (N + 31) / 32, kb = item / nblk, nb = item % nblk, k0 = 64 * kb, n0 = 32 * nb;
    float tv[32];
    { const int n = n0 + (lane & 31); const bool ok = n < N; const float* wp = W + (size_t)(k0 + (lane >> 5)) * N + (ok ? n : 0);
#pragma unroll
      for (int i = 0; i < 32; ++i) tv[i] = wp[(size_t)(2 * i) * N];
#pragma unroll
      for (int i = 0; i < 32; ++i) { const int kk = 2 * i + (lane >> 5); float v = ok ? tv[i] : 0.f; if (MODE == 2) v *= gk[k0 + kk]; scr[kk * 33 + (lane & 31)] = v; } }
    asm volatile("s_waitcnt lgkmcnt(0)" ::: "memory");
    const int c = lane & 7;
#pragma unroll
    for (int j = 0; j < 4; ++j) { const int nl = (lane >> 3) + 8 * j, n = n0 + nl; const LAS float* s = scr + (8 * c) * 33 + nl;
        if (n < N) { int dn = n; if (MODE == 1) dn = (n < 3584) ? n : ((n < 3592) ? (C_I + (n - 3584)) : (n - 8));
            u32x4 o; o.x = pk2(s[0 * 33], s[1 * 33]); o.y = pk2(s[2 * 33], s[3 * 33]); o.z = pk2(s[4 * 33], s[5 * 33]); o.w = pk2(s[6 * 33], s[7 * 33]);
            *(u32x4*)(WT + (size_t)dn * K + k0 + 8 * c) = o; } }
    asm volatile("s_waitcnt lgkmcnt(0)" ::: "memory");
}
struct P0Args { const float *x, *g1, *w_in, *wba, *wbm, *wo, *g2, *wup, *wdn; bf16 *WinT, *WbaT, *WbmT, *WoT, *WupT, *WdnT, *H; float *rss1, *rss2; };
__device__ __forceinline__ void p0_prologue(const P0Args& a, LAS unsigned char* lds, int tid, int G) {
    const int lane = tid & 63, wave = tid >> 6;
    LAS float* scr = (LAS float*)(lds + wave * 16384);
    const int gw = blockIdx.x * 8 + wave, NGW = G * 8;
    constexpr int I_IN = (DM / 64) * ((NPROJ + 31) / 32), I_BA = (512 / 64) * (DM / 32), I_O = (DM / 64) * (DM / 32), I_UP = (DM / 64) * (NUP / 32), I_DN = (DFF / 64) * (DM / 32);
    constexpr int NITEMS = I_IN + 2 * I_BA + I_O + I_UP + I_DN;
    for (int it = gw; it < NITEMS; it += NGW) {
        int r = it;
        if (r < I_IN) { transpose_item<1>(a.w_in, DM, NPROJ, a.WinT, scr, r, lane, nullptr); continue; } r -= I_IN;
        if (r < I_BA) { transpose_item<0>(a.wba, 512, DM, a.WbaT, scr, r, lane, nullptr); continue; } r -= I_BA;
        if (r < I_BA) { transpose_item<0>(a.wbm, 512, DM, a.WbmT, scr, r, lane, nullptr); continue; } r -= I_BA;
        if (r < I_O) { transpose_item<0>(a.wo, DM, DM, a.WoT, scr, r, lane, nullptr); continue; } r -= I_O;
        if (r < I_UP) { transpose_item<2>(a.wup, DM, NUP, a.WupT, scr, r, lane, a.g2); continue; } r -= I_UP;
        transpose_item<0>(a.wdn, DFF, DM, a.WdnT, scr, r, lane, nullptr);
    }
    for (int m = gw; m < MT; m += NGW) {
        const f32x4* xr = (const f32x4*)(a.x + (size_t)m * DM) + lane; f32x4 v[4]; float s = 0.f;
#pragma unroll
        for (int j = 0; j < 4; ++j) { v[j] = xr[64 * j]; s += (v[j][0] * v[j][0] + v[j][1] * v[j][1]) + (v[j][2] * v[j][2] + v[j][3] * v[j][3]); }
        const float rstd = rsqrtf(wave_sum(s) * (1.0f / DM) + EPS);
        u32x2* o8 = (u32x2*)(a.H + (size_t)m * DM) + lane;
#pragma unroll
        for (int j = 0; j < 4; ++j) { const f32x4 g = *((const f32x4*)a.g1 + lane + 64 * j); u32x2 w; w.x = pk2(v[j][0] * rstd * g[0], v[j][1] * rstd * g[1]); w.y = pk2(v[j][2] * rstd * g[2], v[j][3] * rstd * g[3]); o8[64 * j] = w; }
    }
    for (int i = blockIdx.x * 512 + tid; i < MT; i += G * 512) { a.rss1[i] = 0.f; a.rss2[i] = 0.f; }
}

struct P2Args { bf16* P; const int* pos; const float *conv_m, *i_bias, *f_bias; bf16 *QM, *KM; float *GA, *GB, *ST, *KSUM; };
__device__ __forceinline__ void p2_unit(const P2Args& a, LAS unsigned char* lds, int tid, int cu) {
    const int lane = tid & 63, wave = tid >> 6;
    const int b = cu >> 6, c = cu & 63, t0 = b * SEQ + c * 64;
    LAS float* cs = (LAS float*)lds;
    LAS float* sn = cs + 2048;
    LAS float* ks2 = sn + 2048;
    for (int e = tid; e < 2048; e += 512) { const int tok = e >> 5, i = e & 31; const float invf = powf(10000.0f, -(float)i * (1.0f / 32.0f));
        const float ang = (float)a.pos[t0 + tok] * invf; float sv, cv; sincosf(ang, &sv, &cv); cs[e] = cv; sn[e] = sv; }
    __syncthreads();
    {
        const int isk = tid >> 8, hh = (tid & 255) >> 5, i = tid & 31; const int col = (isk ? C_KA : C_QA) + hh * 64 + i; const float sc = isk ? 1.0f : QSCALE;
        float s1 = 0.f, s2 = 0.f;
        for (int tok = 0; tok < 64; ++tok) { bf16* p = a.P + (size_t)(t0 + tok) * NPROJ + col; const float v1 = bf2f(p[0]), v2 = bf2f(p[32]);
            const float cv = cs[tok * 32 + i], sv = sn[tok * 32 + i]; const float o1 = v1 * cv - v2 * sv, o2 = v2 * cv + v1 * sv;
            p[0] = f2bf(o1 * sc); p[32] = f2bf(o2 * sc); s1 += o1; s2 += o2; }
        if (isk) { float* kd = a.KSUM + ((size_t)(b * 8 + hh) * 64 + c) * 64; kd[i] = s1; kd[i + 32] = s2; }
    }
    {
#pragma unroll
        for (int qk = 0; qk < 2; ++qk) { const int ch = qk * 512 + tid; const int col = (qk ? C_KM : C_QM) + tid;
            const float w0 = a.conv_m[ch], w1 = a.conv_m[1024 + ch], w2 = a.conv_m[2048 + ch], w3 = a.conv_m[3072 + ch];
            float x0 = 0.f, x1 = 0.f, x2 = 0.f;
            if (c > 0) { x0 = bf2f(a.P[(size_t)(t0 - 3) * NPROJ + col]); x1 = bf2f(a.P[(size_t)(t0 - 2) * NPROJ + col]); x2 = bf2f(a.P[(size_t)(t0 - 1) * NPROJ + col]); }
            bf16* dst = (qk ? a.KM : a.QM) + (size_t)t0 * 512 + tid; const float osc = qk ? 0.08838834764831845f : 1.0f;
            for (int tok = 0; tok < 64; ++tok) { const float x3 = bf2f(a.P[(size_t)(t0 + tok) * NPROJ + col]);
                const float y = w0 * x0 + w1 * x1 + w2 * x2 + w3 * x3; dst[(size_t)tok * 512] = f2bf(siluf_(y) * osc); x0 = x1; x1 = x2; x2 = x3; } }
    }
    if (wave < 4) {
        const int hh = wave; const size_t prow = (size_t)(t0 + lane) * NPROJ;
        const float av = bf2f(a.P[prow + C_I + hh]) + a.i_bias[hh]; const float fp = bf2f(a.P[prow + C_F + hh]) + a.f_bias[hh];
        const float lf = fminf(fp, 0.f) - log1pf(__expf(-fabsf(fp)));
        float bc = lf;
#pragma unroll
        for (int o = 1; o < 64; o <<= 1) { const float t = __shfl_up(bc, o); if (lane >= o) bc += t; }
        const float blast = __shfl(bc, 63); const float md = wave_max(blast - bc + av);
        const size_t gi = (size_t)(b * 4 + hh) * SEQ + c * 64 + lane; a.GA[gi] = av; a.GB[gi] = bc;
        if (lane == 0) { float* st = a.ST + ((size_t)(b * 4 + hh) * 64 + c) * 2; st[0] = blast; st[1] = md; }
    }
    __syncthreads();
}
struct P3Args { const bf16 *P, *KM; const float *GA, *GB, *ST; float *CT, *NL, *MC, *CSC; };
__device__ __forceinline__ void p3_unit(const P3Args& a, LAS unsigned char* lds, int tid, int un) {
    const int lane = tid & 63, wave = tid >> 6;
    const int bh = un >> 6, c = un & 63, b = bh >> 2, hh = bh & 3, t0 = b * SEQ + c * 64;
    LAS bf16* KT = (LAS bf16*)lds;
    LAS bf16* VT = KT + 128 * 72;
    LAS float* wk = (LAS float*)(VT + 128 * 72);
    LAS float* msc = wk + 64;
    if (wave == 0) {
        const float* st = a.ST + (size_t)bh * 128; const float bl = st[2 * lane], md = st[2 * lane + 1];
        float m = 0.f;
        for (int j = 0; j < c; ++j) m = fmaxf(__shfl(bl, j) + m, __shfl(md, j));
        const float blc = __shfl(bl, c), mdc = __shfl(md, c); const float mnew = fmaxf(blc + m, mdc);
        const size_t gi = (size_t)bh * SEQ + c * 64 + lane;
        wk[lane] = __expf(blc - a.GB[gi] + a.GA[gi] - mnew);
        if (lane == 0) { a.MC[un] = m; a.CSC[un] = __expf(blc + m - mnew); }
    }
    __syncthreads();
#pragma unroll
    for (int k = 0; k < 2; ++k) { const int q = tid + 512 * k, s = q >> 4, dc = (q & 15) * 8;
        const u32x4 kw = *(const u32x4*)(a.KM + (size_t)(t0 + s) * 512 + hh * 128 + dc);
        const u32x4 vw = *(const u32x4*)(a.P + (size_t)(t0 + s) * NPROJ + C_VM + hh * 128 + dc);
        const float w = wk[s]; f32x4 k0, k1; unpack8(kw, k0, k1);
#pragma unroll
        for (int e = 0; e < 4; ++e) { KT[(dc + e) * 72 + s] = f2bf(k0[e] * w); KT[(dc + 4 + e) * 72 + s] = f2bf(k1[e] * w); }
        const unsigned vv[4] = {vw.x, vw.y, vw.z, vw.w};
#pragma unroll
        for (int e = 0; e < 4; ++e) { VT[(dc + 2 * e) * 72 + s] = (bf16)(vv[e] & 0xffffu); VT[(dc + 2 * e + 1) * 72 + s] = (bf16)(vv[e] >> 16); } }
    __syncthreads();
    if (tid < 128) { float s = 0.f; for (int j = 0; j < 64; ++j) s += bf2f(KT[tid * 72 + j]); a.NL[(size_t)un * 128 + tid] = s; }
    {
        const int vt = wave >> 1, r = lane & 31, h = lane >> 5;
#pragma unroll
        for (int dd = 0; dd < 2; ++dd) { const int dt = 2 * (wave & 1) + dd; f32x16 acc; for (int i = 0; i < 16; ++i) acc[i] = 0.f;
            acc = mma32(acc, VT + 32 * vt * 72, 72, KT + 32 * dt * 72, 72, 4, lane);
            float* o = a.CT + (size_t)un * 16384 + 32 * dt + r;
#pragma unroll
            for (int i = 0; i < 16; ++i) o[(size_t)(32 * vt + crow(i, h)) * 128] = acc[i]; }
    }
    __syncthreads();
}
__device__ __forceinline__ void p4_scan(float* CT, float* NL, const float* CSC, int tid, int G) {
    const int gt = blockIdx.x * 512 + tid, NT = G * 512;
    for (int it = gt; it < 16 * 8192; it += NT) { const int bh = it >> 13, e2 = it & 8191;
        float* p = CT + (size_t)bh * 64 * 16384 + 2 * e2; const float* cs = CSC + bh * 64; float c0 = 0.f, c1 = 0.f;
#pragma unroll 8
        for (int c = 0; c < 64; ++c) { const float2 l = *(const float2*)(p + (size_t)c * 16384); *(float2*)(p + (size_t)c * 16384) = make_float2(c0, c1); const float s = cs[c]; c0 = s * c0 + l.x; c1 = s * c1 + l.y; } }
    for (int it = gt; it < 16 * 128; it += NT) { const int bh = it >> 7, e = it & 127; float* p = NL + (size_t)bh * 64 * 128 + e; const float* cs = CSC + bh * 64; float n0 = 0.f;
        for (int c = 0; c < 64; ++c) { const float l = p[c * 128]; p[c * 128] = n0; n0 = cs[c] * n0 + l; } }
}
struct P5Args { bf16* P; const bf16 *QM, *KM; const float *GA, *GB, *CT, *NL, *MC, *ng; };
__device__ __forceinline__ void p5_unit(const P5Args& a, LAS unsigned char* lds, int tid, int un) {
    const int lane = tid & 63, wave = tid >> 6, r = lane & 31, h = lane >> 5;
    const int bh = un >> 6, c = un & 63, b = bh >> 2, hh = bh & 3, t0 = b * SEQ + c * 64;
    LAS bf16* Qs = (LAS bf16*)lds;
    LAS bf16* Ks = Qs + 64 * 136;
    LAS bf16* VT = Ks + 64 * 136;
    LAS bf16* Et = VT + 128 * 72;
    LAS bf16* Ps = Et + 128 * 136;
    LAS float* fa = (LAS float*)(Ps + 64 * 72);
    LAS float* fb = fa + 64;
    LAS float* fmt = fb + 64;
    LAS float* fwi = fmt + 64;
    LAS float* fqn = fwi + 64;
    LAS float* frs = fqn + 64;
    LAS float* fss = frs + 128;
    LAS float* fnp = fss + 256;
    const float mc = a.MC[un];
#pragma unroll
    for (int k = 0; k < 2; ++k) { const int q = tid + 512 * k, s = q >> 4, dc = (q & 15) * 8;
        *(LAS u32x4*)(Qs + s * 136 + dc) = *(const u32x4*)(a.QM + (size_t)(t0 + s) * 512 + hh * 128 + dc);
        *(LAS u32x4*)(Ks + s * 136 + dc) = *(const u32x4*)(a.KM + (size_t)(t0 + s) * 512 + hh * 128 + dc);
        const u32x4 vw = *(const u32x4*)(a.P + (size_t)(t0 + s) * NPROJ + C_VM + hh * 128 + dc);
        const unsigned vv[4] = {vw.x, vw.y, vw.z, vw.w};
#pragma unroll
        for (int e = 0; e < 4; ++e) { VT[(dc + 2 * e) * 72 + s] = (bf16)(vv[e] & 0xffffu); VT[(dc + 2 * e + 1) * 72 + s] = (bf16)(vv[e] >> 16); } }
#pragma unroll
    for (int k = 0; k < 4; ++k) { const int q = tid + 512 * k, v = q >> 4, dc = (q & 15) * 8; const float* src = a.CT + (size_t)un * 16384 + v * 128 + dc;
        const f32x4 e0 = *(const f32x4*)src, e1 = *(const f32x4*)(src + 4); *(LAS u32x4*)(Et + v * 136 + dc) = pack8(e0, e1); }
    if (tid < 128) fnp[tid] = a.NL[(size_t)un * 128 + tid];
    if (tid < 64) { const size_t gi = (size_t)bh * SEQ + c * 64 + tid; fa[tid] = a.GA[gi]; fb[tid] = a.GB[gi]; }
    __syncthreads();
    if (tid < 64) { const int l = tid; float pm = NEGF; for (int s = 0; s <= l; ++s) pm = fmaxf(pm, fa[s] - fb[s]);
        const float bl = fb[l], mt = fmaxf(bl + mc, bl + pm); fmt[l] = mt; fwi[l] = __expf(bl + mc - mt);
        float qn = 0.f; for (int d = 0; d < 128; ++d) qn += bf2f(Qs[l * 136 + d]) * fnp[d]; fqn[l] = qn; }
    __syncthreads();
    if (wave < 4) {
        const int lt = wave & 1, st = wave >> 1; f32x16 acc; for (int i = 0; i < 16; ++i) acc[i] = 0.f;
        acc = mma32(acc, Qs + 32 * lt * 136, 136, Ks + 32 * st * 136, 136, 8, lane);
        const int s = 32 * st + r; const float as = fa[s], bs = fb[s];
#pragma unroll
        for (int i = 0; i < 16; ++i) { const int l = 32 * lt + crow(i, h);
            float sc = 0.f; if (s <= l) sc = __expf(fb[l] - bs + as - fmt[l]) * acc[i];
            const bf16 sb = f2bf(sc); Ps[l * 72 + s] = sb; const float rsum = red32_sum(bf2f(sb)); if (r == 0) frs[st * 64 + l] = rsum; }
    }
    __syncthreads();
    {
        const int lt = wave & 1, vt = wave >> 1; f32x16 ae, as_; for (int i = 0; i < 16; ++i) { ae[i] = 0.f; as_[i] = 0.f; }
        ae = mma32(ae, Qs + 32 * lt * 136, 136, Et + 32 * vt * 136, 136, 8, lane);
        as_ = mma32(as_, Ps + 32 * lt * 72, 72, VT + 32 * vt * 72, 72, 4, lane);
        float hv[16];
#pragma unroll
        for (int i = 0; i < 16; ++i) { const int l = 32 * lt + crow(i, h); const float wi = fwi[l]; const float den = wi * fqn[l] + frs[l] + frs[64 + l];
            const float dn = fmaxf(fabsf(den), __expf(-fmt[l])); hv[i] = (wi * ae[i] + as_[i]) / dn;
            const float sq = red32_sum(hv[i] * hv[i]); if (r == 0) fss[vt * 64 + l] = sq; }
        __syncthreads();
        const int v = 32 * vt + r; const float gv = a.ng[hh * 128 + v];
#pragma unroll
        for (int i = 0; i < 16; ++i) { const int l = 32 * lt + crow(i, h); const float ss = fss[l] + fss[64 + l] + fss[128 + l] + fss[192 + l];
            const float rstd = rsqrtf(ss * (1.0f / 128.0f) + EPS); const size_t prow = (size_t)(t0 + l) * NPROJ;
            const float om = bf2f(a.P[prow + C_OM + hh * 128 + v]); a.P[prow + C_QM + hh * 128 + v] = f2bf(hv[i] * rstd * gv * sigmoidf_(om)); }
    }
    __syncthreads();
}
struct AtArgs { bf16* P; const float* KSUM; };
__device__ __forceinline__ void attn_unit(const AtArgs& a, LAS unsigned char* lds, int tid, int bh, int j) {
    const int lane = tid & 63, wave = tid >> 6, r = lane & 31, h = lane >> 5;
    const int b = bh >> 3, hh = bh & 7, q0 = b * SEQ + j * 256;
    LAS float* kmean = (LAS float*)lds;
    LAS unsigned* qmask = (LAS unsigned*)(kmean + 1024);
    LAS unsigned* anym = qmask + 256;
    LAS bf16* Kb = (LAS bf16*)(anym + 8);
    LAS bf16* Vb = Kb + 2 * 64 * 72;
    LAS bf16* Pw = Vb + 2 * 64 * 72 + wave * 32 * 72;
    for (int e = tid; e < 1024; e += 512) { const int n = e >> 6, d = e & 63; const float* ks = a.KSUM + ((size_t)bh * 64 + n * 4) * 64 + d; kmean[e] = (ks[0] + ks[64] + ks[128] + ks[192]) * (1.0f / 256.0f); }
    __syncthreads();
    if (tid < 256) {
        unsigned msk = 0u;
        if (j > 0) {
            float qv[64]; const bf16* qp = a.P + (size_t)(q0 + tid) * NPROJ + C_QA + hh * 64;
#pragma unroll
            for (int k = 0; k < 8; ++k) { const u32x4 w = *(const u32x4*)(qp + 8 * k); f32x4 x0, x1; unpack8(w, x0, x1);
#pragma unroll
                for (int e = 0; e < 4; ++e) { qv[8 * k + e] = x0[e]; qv[8 * k + 4 + e] = x1[e]; } }
            float v0 = -3e38f, v1 = -3e38f, v2 = -3e38f; int i0 = -1, i1 = -1, i2 = -1;
            for (int n = 0; n < j; ++n) { float g = 0.f;
#pragma unroll
                for (int d = 0; d < 64; ++d) g += qv[d] * kmean[n * 64 + d];
                if (g > v0) { v2 = v1; i2 = i1; v1 = v0; i1 = i0; v0 = g; i0 = n; } else if (g > v1) { v2 = v1; i2 = i1; v1 = g; i1 = n; } else if (g > v2) { v2 = g; i2 = n; } }
            if (i0 >= 0) msk |= 1u << i0; if (i1 >= 0) msk |= 1u << i1; if (i2 >= 0) msk |= 1u << i2;
        }
        qmask[tid] = msk;
        unsigned om = msk;
#pragma unroll
        for (int o = 1; o < 64; o <<= 1) om |= __shfl_xor(om, o);
        if (lane == 0) anym[wave] = om;
    }
    __syncthreads();
    const unsigned blkmask = (anym[0] | anym[1] | anym[2] | anym[3]) | (1u << j);
    const unsigned mymask = qmask[32 * wave + r];
    bf16x8 bq[4];
    { const bf16* qp = a.P + (size_t)(q0 + 32 * wave + r) * NPROJ + C_QA + hh * 64 + 8 * h;
#pragma unroll
      for (int ks = 0; ks < 4; ++ks) bq[ks] = *(const bf16x8*)(qp + 16 * ks); }
    f32x16 o0, o1; for (int i = 0; i < 16; ++i) { o0[i] = 0.f; o1[i] = 0.f; }
    float mrun = NEGF, lrun = 0.f;
    const int srow = tid >> 3, sch = (tid & 7) * 8;
    const bf16* kbase = a.P + (size_t)(b * SEQ) * NPROJ + C_KA + hh * 64 + sch;
    const bf16* vbase = a.P + (size_t)(b * SEQ) * NPROJ + C_VA + hh * 64 + sch;
    unsigned rem = blkmask; int n = __builtin_ctz(rem), t = 0; rem &= rem - 1;
    u32x4 kreg = *(const u32x4*)(kbase + (size_t)(n * 256 + t * 64 + srow) * NPROJ), vreg = *(const u32x4*)(vbase + (size_t)(n * 256 + t * 64 + srow) * NPROJ);
    int buf = 0;
    for (;;) {
        LAS bf16* Kc = Kb + buf * 64 * 72; LAS bf16* Vc = Vb + buf * 64 * 72;
        *(LAS u32x4*)(Kc + srow * 72 + sch) = kreg;
        { const unsigned vv[4] = {vreg.x, vreg.y, vreg.z, vreg.w};
#pragma unroll
          for (int e = 0; e < 4; ++e) { Vc[(sch + 2 * e) * 72 + srow] = (bf16)(vv[e] & 0xffffu); Vc[(sch + 2 * e + 1) * 72 + srow] = (bf16)(vv[e] >> 16); } }
        __syncthreads();
        const int cn = n, ct = t;
        bool more = true; if (t < 3) ++t; else if (rem) { n = __builtin_ctz(rem); rem &= rem - 1; t = 0; } else more = false;
        if (more) { kreg = *(const u32x4*)(kbase + (size_t)(n * 256 + t * 64 + srow) * NPROJ); vreg = *(const u32x4*)(vbase + (size_t)(n * 256 + t * 64 + srow) * NPROJ); }
        const bool own = (cn == j);
        const bool active = own ? (2 * ct <= wave) : true;
        if (active) {
            f32x16 s0, s1; for (int i = 0; i < 16; ++i) { s0[i] = 0.f; s1[i] = 0.f; }
            { const LAS bf16* kp0 = Kc + r * 72 + 8 * h; const LAS bf16* kp1 = kp0 + 32 * 72;
#pragma unroll
              for (int ks = 0; ks < 4; ++ks) { s0 = __builtin_amdgcn_mfma_f32_32x32x16_bf16(*(const LAS bf16x8*)(kp0 + 16 * ks), bq[ks], s0, 0, 0, 0);
                                               s1 = __builtin_amdgcn_mfma_f32_32x32x16_bf16(*(const LAS bf16x8*)(kp1 + 16 * ks), bq[ks], s1, 0, 0, 0); } }
            const bool sel = own ? true : (((mymask >> cn) & 1u) != 0u);
            if (own) { const int qrel = 32 * wave + r - 64 * ct;
#pragma unroll
                for (int i = 0; i < 16; ++i) { const int kk = crow(i, h); if (kk > qrel) s0[i] = NEGF; if (kk + 32 > qrel) s1[i] = NEGF; } }
            float tm = NEGF;
#pragma unroll
            for (int i = 0; i < 16; ++i) tm = fmaxf(tm, fmaxf(s0[i], s1[i]));
            tm = fmaxf(tm, __shfl_xor(tm, 32));
            const float mnew = sel ? fmaxf(mrun, tm) : mrun;
            const float alpha = exp2f(mrun - mnew);
            float ps = 0.f;
#pragma unroll
            for (int i = 0; i < 16; ++i) { const float p0 = sel ? exp2f(s0[i] - mnew) : 0.f, p1 = sel ? exp2f(s1[i] - mnew) : 0.f; s0[i] = p0; s1[i] = p1; ps += p0 + p1; }
            lrun = lrun * alpha + ps; mrun = mnew;
#pragma unroll
            for (int i = 0; i < 16; ++i) { o0[i] *= alpha; o1[i] *= alpha; }
#pragma unroll
            for (int g = 0; g < 4; ++g) { u32x2 w0, w1; w0.x = cvt_pk_bf16(s0[4 * g], s0[4 * g + 1]); w0.y = cvt_pk_bf16(s0[4 * g + 2], s0[4 * g + 3]); w1.x = cvt_pk_bf16(s1[4 * g], s1[4 * g + 1]); w1.y = cvt_pk_bf16(s1[4 * g + 2], s1[4 * g + 3]);
                *(LAS u32x2*)(Pw + r * 72 + 8 * g + 4 * h) = w0; *(LAS u32x2*)(Pw + r * 72 + 32 + 8 * g + 4 * h) = w1; }
            asm volatile("s_waitcnt lgkmcnt(0)" ::: "memory");
            o0 = mma32(o0, Vc, 72, Pw, 72, 4, lane);
            o1 = mma32(o1, Vc + 32 * 72, 72, Pw, 72, 4, lane);
        }
        if (!more) break;
        buf ^= 1;
    }
    lrun += __shfl_xor(lrun, 32);
    const float inv = 1.0f / lrun;
    __syncthreads();
    bf16* op = a.P + (size_t)(q0 + 32 * wave + r) * NPROJ + C_QA + hh * 64;
#pragma unroll
    for (int g = 0; g < 4; ++g) { u32x2 w0, w1; w0.x = cvt_pk_bf16(o0[4 * g] * inv, o0[4 * g + 1] * inv); w0.y = cvt_pk_bf16(o0[4 * g + 2] * inv, o0[4 * g + 3] * inv);
        w1.x = cvt_pk_bf16(o1[4 * g] * inv, o1[4 * g + 1] * inv); w1.y = cvt_pk_bf16(o1[4 * g + 2] * inv, o1[4 * g + 3] * inv);
        *(u32x2*)(op + 8 * g + 4 * h) = w0; *(u32x2*)(op + 32 + 8 * g + 4 * h) = w1; }
    __syncthreads();
}
__device__ __forceinline__ void p9_conv(const bf16* U, bf16* Gh, const float* cw, int tid, int G) {
    const int gt = blockIdx.x * 512 + tid, NT = G * 512;
    for (int it = gt; it < 256 * 352; it += NT) { const int ch = it / 352, cg8 = (it % 352) * 8; const int r0 = ch * 32; const bool first = (r0 & (SEQ - 1)) == 0;
        f32x4 wg[3][2], wu[3][2];
#pragma unroll
        for (int k = 0; k < 3; ++k) { wg[k][0] = *(const f32x4*)(cw + k * NUP + cg8); wg[k][1] = *(const f32x4*)(cw + k * NUP + cg8 + 4); wu[k][0] = *(const f32x4*)(cw + k * NUP + DFF + cg8); wu[k][1] = *(const f32x4*)(cw + k * NUP + DFF + cg8 + 4); }
        f32x4 g0[2], g1[2], u0[2], u1[2];
        if (first) { for (int e = 0; e < 2; ++e) { g0[e] = (f32x4){0.f, 0.f, 0.f, 0.f}; g1[e] = g0[e]; u0[e] = g0[e]; u1[e] = g0[e]; } }
        else { unpack8(*(const u32x4*)(U + (size_t)(r0 - 2) * NUP + cg8), g0[0], g0[1]); unpack8(*(const u32x4*)(U + (size_t)(r0 - 1) * NUP + cg8), g1[0], g1[1]);
               unpack8(*(const u32x4*)(U + (size_t)(r0 - 2) * NUP + DFF + cg8), u0[0], u0[1]); unpack8(*(const u32x4*)(U + (size_t)(r0 - 1) * NUP + DFF + cg8), u1[0], u1[1]); }
#pragma unroll 4
        for (int t = 0; t < 32; ++t) { f32x4 g2[2], u2[2]; unpack8(*(const u32x4*)(U + (size_t)(r0 + t) * NUP + cg8), g2[0], g2[1]); unpack8(*(const u32x4*)(U + (size_t)(r0 + t) * NUP + DFF + cg8), u2[0], u2[1]);
            f32x4 o[2];
#pragma unroll
            for (int e = 0; e < 2; ++e) { const f32x4 gg = wg[0][e] * g0[e] + wg[1][e] * g1[e] + wg[2][e] * g2[e]; const f32x4 uu = wu[0][e] * u0[e] + wu[1][e] * u1[e] + wu[2][e] * u2[e];
                o[e] = (f32x4){siluf_(gg[0]) * uu[0], siluf_(gg[1]) * uu[1], siluf_(gg[2]) * uu[2], siluf_(gg[3]) * uu[3]}; g0[e] = g1[e]; g1[e] = g2[e]; u0[e] = u1[e]; u1[e] = u2[e]; }
            *(u32x4*)(Gh + (size_t)(r0 + t) * DFF + cg8) = pack8(o[0], o[1]); }
    }
}
__device__ __forceinline__ void p11_final(float* out, const float* rss2, const float* gf, int tid, int G) {
    const int lane = tid & 63, wave = tid >> 6; const int gw = blockIdx.x * 8 + wave, NGW = G * 8;
    for (int m = gw; m < MT; m += NGW) { const float rstd = rsqrtf(rss2[m] * (1.0f / DM) + EPS); f32x4* xr = (f32x4*)(out + (size_t)m * DM) + lane;
#pragma unroll
        for (int jj = 0; jj < 4; ++jj) { const f32x4 g = *((const f32x4*)gf + lane + 64 * jj); xr[64 * jj] = xr[64 * jj] * rstd * g; } }
}

struct Args { const float* in[16]; float* out; unsigned char* ws; int use_cg; int pad; };
#define GSYNC() grid.sync()
#ifndef PROBE
#define PROBE 0
#endif
#ifndef PROBE_K
#define PROBE_K 1
#endif
#define PB(n) do { if (PROBE == (n)) pt0 = __builtin_amdgcn_s_memrealtime(); } while (0)
#define PE(n) do { if (PROBE == (n)) pdt += __builtin_amdgcn_s_memrealtime() - pt0; } while (0)
#define XB_TMO      128
#define XB_XCNT(j)  (256  + 64 * (j))
#define XB_XSUB(j)  (1280 + 64 * (j))
#define XB_XGEN(j)  (2304 + 64 * (j))
#define XB_TOP      3328
#define XB_TOPGEN   3392
#define XCD_BAR_WORDS 3456
#define XB_SPIN_CAP (1u << 18)

__device__ __forceinline__ unsigned xb_ld(unsigned* p)              { return __hip_atomic_load(p, __ATOMIC_RELAXED, __HIP_MEMORY_SCOPE_AGENT); }
__device__ __forceinline__ unsigned xb_add(unsigned* p, unsigned v) { return __hip_atomic_fetch_add(p, v, __ATOMIC_RELAXED, __HIP_MEMORY_SCOPE_AGENT); }
__device__ __forceinline__ unsigned xb_xcc_id() { return (unsigned)__builtin_amdgcn_s_getreg((3 << 11) | 20) & 0xFu; }
#define XB_SPIN(cond, bar) do { unsigned _sp = 0; while (cond) { __builtin_amdgcn_s_sleep(1); \
    if ((++_sp & 255u) == 0u) { if (xb_ld(&(bar)[XB_TMO])) break; if (_sp > XB_SPIN_CAP) { atomicAdd(&(bar)[XB_TMO], 1u); break; } } } } while (0)

struct XcdBarrier {
    unsigned* bar; unsigned x;
    volatile LAS unsigned* st;
};

__device__ __forceinline__ XcdBarrier xcd_barrier_post(unsigned* bar, volatile LAS unsigned* st) {
    XcdBarrier b; b.bar = bar; b.x = xb_xcc_id(); b.st = st;
    if (threadIdx.x == 0) (void)xb_add(&bar[XB_XCNT(b.x)], 1u);
    return b;
}
__device__ __forceinline__ void xcd_barrier_complete(unsigned* bar, unsigned x, unsigned& nloc, unsigned& nx) {
    const unsigned G = gridDim.x * gridDim.y * gridDim.z;
    unsigned sum, cnt, mine, sp = 0u;
    for (;;) {
        sum = 0u; cnt = 0u; mine = 0u;
#pragma unroll
        for (unsigned j = 0; j < 16; ++j) { const unsigned c = xb_ld(&bar[XB_XCNT(j)]); sum += c; cnt += (c > 0u) ? 1u : 0u; mine = (j == x) ? c : mine; }
        if (sum == G) break;
        __builtin_amdgcn_s_sleep(1);
        if ((++sp & 255u) == 0u) { if (xb_ld(&bar[XB_TMO])) break; if (sp > XB_SPIN_CAP) { atomicAdd(&bar[XB_TMO], 1u); break; } }
    }
    nloc = mine > 0u ? mine : 1u; nx = cnt > 0u ? cnt : 1u;
}

__device__ __forceinline__ void xcd_barrier(const XcdBarrier& b) {
    asm volatile("s_waitcnt vmcnt(0)" ::: "memory");
    __syncthreads();
    if (threadIdx.x == 0) {
        unsigned* bar = b.bar;
        __builtin_amdgcn_s_waitcnt(0);
        unsigned nloc = b.st[0], nx = b.st[1];
        if (nloc == 0u) { xcd_barrier_complete(bar, b.x, nloc, nx); b.st[0] = nloc; b.st[1] = nx; }
        const unsigned old = xb_add(&bar[XB_XSUB(b.x)], 1u);
        const unsigned gen = old / nloc;
        if (old + 1u == (gen + 1u) * nloc) {
            __builtin_amdgcn_fence(__ATOMIC_RELEASE, "agent");
            asm volatile("s_waitcnt vmcnt(0)" ::: "memory");
            const unsigned og = xb_add(&bar[XB_TOP], 1u);
            const unsigned tg = og / nx;
            if (og + 1u == (tg + 1u) * nx) xb_add(&bar[XB_TOPGEN], 1u);
            else XB_SPIN(xb_ld(&bar[XB_TOPGEN]) == tg, bar);
            __builtin_amdgcn_fence(__ATOMIC_ACQUIRE, "agent");
            xb_add(&bar[XB_XGEN(b.x)], 1u);
            asm volatile("s_waitcnt vmcnt(0)" ::: "memory");
        } else {
            XB_SPIN(xb_ld(&bar[XB_XGEN(b.x)]) == gen, bar);
            __builtin_amdgcn_fence(__ATOMIC_ACQUIRE, "agent");
            asm volatile("s_waitcnt vmcnt(0)" ::: "memory");
        }
    }
    __syncthreads();
}

__device__ __forceinline__ unsigned long long karg(int i) { const volatile unsigned long long* ka = (const volatile unsigned long long*)__builtin_amdgcn_kernarg_segment_ptr(); const unsigned long long v = ka[i]; const unsigned lo = __builtin_amdgcn_readfirstlane((unsigned)v), hi = __builtin_amdgcn_readfirstlane((unsigned)(v >> 32)); return ((unsigned long long)hi << 32) | lo; }
#define KIN(i) ((const float*)karg(i))
#define KOUT() ((float*)karg(16))
#define KWS(off) ((unsigned char*)karg(17) + (off))
__global__ void __launch_bounds__(512) fwd_mega(Args args) {
    extern __shared__ __attribute__((aligned(16))) unsigned char lds_raw[];
    cg::grid_group grid = cg::this_grid();
    LAS unsigned char* lds = (LAS unsigned char*)lds_raw;
    const int tid = threadIdx.x, G = gridDim.x;
    unsigned long long pt0 = 0, pdt = 0;
    if (tid < 2) ((volatile LAS unsigned*)(lds + 131072 + 512))[tid] = 0u;
    __syncthreads();
    XcdBarrier xbar = xcd_barrier_post((unsigned*)KWS(WS_BAR), (volatile LAS unsigned*)(lds + 131072 + 512));
    PB(1);
    { P0Args a{KIN(0), KIN(2), KIN(3), KIN(8), KIN(9), KIN(10), KIN(11), KIN(12), KIN(14), (bf16*)KWS(WS_WIN), (bf16*)KWS(WS_WBA), (bf16*)KWS(WS_WBM), (bf16*)KWS(WS_WO), (bf16*)KWS(WS_WUP), (bf16*)KWS(WS_WDN), (bf16*)KWS(WS_H), (float*)KWS(WS_RSS1), (float*)KWS(WS_RSS2)};
      p0_prologue(a, lds, tid, G); }
    if (__builtin_expect((int)karg(18) != 0, 0)) GSYNC(); else xcd_barrier(xbar);
    PE(1);
    PB(2);
    { pg8::Gemm g{(const bf16*)KWS(WS_H), (const bf16*)KWS(WS_WIN), MT, NPROJ_PAD, DM, DM, DM}; pg8::StaticOrder S; S.init(MT, NPROJ_PAD, G, (int)blockIdx.x); EpiProj E{(bf16*)KWS(WS_PROJ)};
      pg8::gemm_phase<EpiProj, pg8::StaticOrder, true, true>(lds, g, S, E); }
    xcd_barrier(xbar);
    PE(2);
    PB(3);
    { P2Args a{(bf16*)KWS(WS_PROJ), (const int*)karg(1), KIN(4), KIN(5), KIN(6), (bf16*)KWS(WS_QM), (bf16*)KWS(WS_KM), (float*)KWS(WS_GA), (float*)KWS(WS_GB), (float*)KWS(WS_ST), (float*)KWS(WS_KSUM)};
      for (int u = blockIdx.x; u < 256; u += G) p2_unit(a, lds, tid, u); }
    xcd_barrier(xbar);
    PE(3);
    PB(4);
    { P3Args a{(const bf16*)KWS(WS_PROJ), (const bf16*)KWS(WS_KM), (const float*)KWS(WS_GA), (const float*)KWS(WS_GB), (const float*)KWS(WS_ST), KOUT(), (float*)KWS(WS_NL), (float*)KWS(WS_MC), (float*)KWS(WS_CSC)};
      for (int u = blockIdx.x; u < 1024; u += G) p3_unit(a, lds, tid, u); }
    PE(4);
    PB(5);
    { AtArgs at{(bf16*)KWS(WS_PROJ), (const float*)KWS(WS_KSUM)};
      for (int p = blockIdx.x; p < 256; p += G) { const int bh = p >> 3, jj = p & 7; attn_unit(at, lds, tid, bh, jj); attn_unit(at, lds, tid, bh, 15 - jj); } }
    xcd_barrier(xbar);
    PE(5);
    PB(6);
    p4_scan(KOUT(), (float*)KWS(WS_NL), (const float*)KWS(WS_CSC), tid, G);
    xcd_barrier(xbar);
    PE(6);
    PB(7);
    { P5Args a{(bf16*)KWS(WS_PROJ), (const bf16*)KWS(WS_QM), (const bf16*)KWS(WS_KM), (const float*)KWS(WS_GA), (const float*)KWS(WS_GB), KOUT(), (const float*)KWS(WS_NL), (const float*)KWS(WS_MC), KIN(7)};
      for (int u = blockIdx.x; u < 1024; u += G) p5_unit(a, lds, tid, u); }
    xcd_barrier(xbar);
    PE(7);
    PB(8);
    { pg8::Gemm g{(const bf16*)KWS(WS_PROJ) + C_QA, (const bf16*)KWS(WS_WBA), MT, DM, 512, NPROJ, 512}; pg8::StaticOrder S; S.init(MT, DM, G, (int)blockIdx.x); EpiGate<false> E{(const bf16*)KWS(WS_PROJ), (bf16*)KWS(WS_MRG), C_GA};
      pg8::gemm_phase<EpiGate<false>, pg8::StaticOrder, true, true>(lds, g, S, E); }
    __syncthreads();
    { pg8::Gemm g{(const bf16*)KWS(WS_PROJ) + C_QM, (const bf16*)KWS(WS_WBM), MT, DM, 512, NPROJ, 512}; pg8::StaticOrder S; S.init(MT, DM, G, (int)blockIdx.x); EpiGate<true> E{(const bf16*)KWS(WS_PROJ), (bf16*)KWS(WS_MRG), C_GM};
      pg8::gemm_phase<EpiGate<true>, pg8::StaticOrder, true, true>(lds, g, S, E); }
    xcd_barrier(xbar);
    PE(8);
    PB(9);
    { pg8::Gemm g{(const bf16*)KWS(WS_MRG), (const bf16*)KWS(WS_WO), MT, DM, DM, DM, DM}; pg8::StaticOrder S; S.init(MT, DM, G, (int)blockIdx.x); EpiRes1 E{KIN(0), KOUT(), (bf16*)KWS(WS_X1B), (float*)KWS(WS_RSS1)};
      pg8::gemm_phase<EpiRes1, pg8::StaticOrder, true, true>(lds, g, S, E); }
    xcd_barrier(xbar);
    PE(9);
    for (int hf = 0; hf < 2; ++hf) {
        PB(10);
        { pg8::Gemm g{(const bf16*)KWS(WS_X1B) + (size_t)hf * 8192 * DM, (const bf16*)KWS(WS_WUP), 8192, NUP, DM, DM, DM}; pg8::StaticOrder S; S.init(8192, NUP, G, (int)blockIdx.x); EpiUp E{(bf16*)KWS(WS_U), (const float*)KWS(WS_RSS1) + hf * 8192};
          pg8::gemm_phase<EpiUp, pg8::StaticOrder, true, true>(lds, g, S, E); }
        xcd_barrier(xbar);
        PE(10);
        PB(11);
        p9_conv((const bf16*)KWS(WS_U), (bf16*)KWS(WS_G) + (size_t)hf * 8192 * DFF, KIN(13), tid, G);
        xcd_barrier(xbar);
        PE(11);
    }
    PB(12);
    { pg8::Gemm g{(const bf16*)KWS(WS_G), (const bf16*)KWS(WS_WDN), MT, DM, DFF, DFF, DFF}; pg8::StaticOrder S; S.init(MT, DM, G, (int)blockIdx.x); EpiRes2 E{KOUT(), (float*)KWS(WS_RSS2)};
      pg8::gemm_phase<EpiRes2, pg8::StaticOrder, true, true>(lds, g, S, E); }
    xcd_barrier(xbar);
    PE(12);
    PB(13);
    p11_final(KOUT(), (const float*)KWS(WS_RSS2), KIN(15), tid, G);
    PE(13);
    if (PROBE == 15) { PB(15); for (int k = 0; k < 8; ++k) xcd_barrier(xbar); PE(15); }
    if (PROBE != 0) { const unsigned long long te = __builtin_amdgcn_s_memrealtime(); while (__builtin_amdgcn_s_memrealtime() - te < pdt * PROBE_K) __builtin_amdgcn_s_sleep(8); }
}

extern "C" void kernel_launch(void* const* d_in, const int* in_sizes, int n_in, void* d_out, int out_size, void* d_ws, size_t ws_size, hipStream_t stream) {
    static int grid = 0;
    if (grid == 0) {
        if (n_in != 16 || out_size != MT * DM || ws_size < WS_END) { fprintf(stderr, "kernel_launch: unexpected shapes n_in %d out %d ws %zu\n", n_in, out_size, ws_size); grid = -1; return; }
        int dev = 0, cus = 0, per = 0;
        (void)hipGetDevice(&dev); (void)hipDeviceGetAttribute(&cus, hipDeviceAttributeMultiprocessorCount, dev);
        (void)hipFuncSetAttribute((const void*)fwd_mega, hipFuncAttributeMaxDynamicSharedMemorySize, LDS_BYTES);
        (void)hipOccupancyMaxActiveBlocksPerMultiprocessor(&per, (const void*)fwd_mega, 512, LDS_BYTES);
        if (per < 1) per = 1;
        grid = cus * per;
        fprintf(stderr, "kernel_launch: grid %d (cus %d x %d)\n", grid, cus, per);
    }
    if (grid < 0) return;
    if (hipMemsetAsync((char*)d_ws + WS_BAR, 0, XCD_BAR_WORDS * 4, stream) != hipSuccess) { fprintf(stderr, "kernel_launch: memset failed\n"); return; }
    Args a{};
    for (int i = 0; i < 16; ++i) a.in[i] = (const float*)d_in[i];
    a.out = (float*)d_out; a.ws = (unsigned char*)d_ws;
    void* kargs[] = {&a};
    hipError_t e = hipLaunchCooperativeKernel((const void*)fwd_mega, dim3(grid), dim3(512), kargs, LDS_BYTES, stream);
    if (e != hipSuccess) fprintf(stderr, "kernel_launch: cooperative launch failed: %s (grid %d)\n", hipGetErrorString(e), grid);
}
```

```cpp
#include <hip/hip_runtime.h>
#include <hip/hip_cooperative_groups.h>
#include <cstdio>
#include <cstdint>
namespace cg = cooperative_groups;
namespace pg8 {
#define PG8_LAS __attribute__((address_space(3)))
typedef unsigned short bf16_t;
typedef short bf16x8 __attribute__((ext_vector_type(8)));
typedef float f32x4 __attribute__((ext_vector_type(4)));
typedef unsigned u32x4 __attribute__((ext_vector_type(4)));
constexpr int BM = 256, BK = 64, HALF = 128, HTB = HALF * BK * 2  , STAGE_BYTES = 8 * HTB, NXCD = 8, WGM = 8;

__host__ __device__ __forceinline__ int lds_byte(int r, int c) { const int st = (r >> 4) * 2 + (c >> 5), rr = r & 15, cc = c & 31, ob = rr * 64 + cc * 2; return st * 1024 + (ob ^ (((ob >> 9) & 1) << 5)); }
__host__ __device__ __forceinline__ void stage_rc(int b, int& R, int& C) { const int st = b / 1024, sb = b % 1024, swz = sb ^ (((sb >> 9) & 1) << 5); R = (st >> 1) * 16 + swz / 64; C = (st & 1) * 32 + (swz % 64) / 2; }
__host__ __device__ __forceinline__ int perm32(int rho) { const int n = rho >> 4, i = rho & 15; return 8 * (i >> 2) + 4 * n + (i & 3); }

struct Unit { int pm, pn; };
struct Gemm { const bf16_t* A; const bf16_t* Bt; int M, N, K, lda, ldb; int a_split_pn; int a_split_off; };

struct StaticOrder {
    int nM, nN, nwg, G, c;
    __host__ __device__ void init(int M, int N, int G_, int c_) { nM = M / BM; nN = N / BM; nwg = nM * nN; G = G_; c = c_; }
    __host__ __device__ bool next(int i, Unit& u) const {
        const long L = (long)i * G + c; if (L >= nwg) return false;
        int wgid = (int)L; { const int q = nwg / NXCD, r = nwg % NXCD, xcd = wgid % NXCD, off = wgid / NXCD; wgid = (xcd < r ? xcd * (q + 1) : r * (q + 1) + (xcd - r) * q) + off; }
        const int nig = WGM * nN, gid = wgid / nig, fm = gid * WGM, gsz = (nM - fm) < WGM ? (nM - fm) : WGM;
        u.pm = fm + ((wgid % nig) % gsz); u.pn = (wgid % nig) / gsz; return true;
    }
    __device__ __forceinline__ void a_ready(const Unit&) const {}
    __device__ __forceinline__ void done(const Unit&) const {}
};

__device__ __forceinline__ unsigned cvt_pk_bf16(float lo, float hi) { unsigned r; asm volatile("v_cvt_pk_bf16_f32 %0, %1, %2" : "=v"(r) : "v"(lo), "v"(hi)); return r; }
template <class Epi, class Sched, bool ALIGN_EPI, bool SP2, int LDA, int LDB, int KK>
__device__ __forceinline__ void gemm_phase(PG8_LAS unsigned char* lds, const Gemm g, const Sched& S, const Epi& E) {
    const int tid = threadIdx.x, wid = __builtin_amdgcn_readfirstlane(tid >> 6), lane = tid & 63, wr = wid >> 2, wc = wid & 3, fr = lane & 15, fq = lane >> 4;
    constexpr int K = KK, nt = K / BK;
    unsigned voffA[2], voffB[2];
#pragma unroll
    for (int i = 0; i < 2; ++i) { int R, C; stage_rc(tid * 16 + i * 8192, R, C); const int Rb = Epi::PERM ? ((R & ~31) + perm32(R & 31)) : R;
        voffA[i] = (unsigned)(R * LDA + C) * 2u; voffB[i] = (unsigned)(Rb * LDB + C) * 2u; }
    constexpr size_t kstep = (size_t)(BK * 2);
    constexpr size_t hstepA = (size_t)HALF * LDA * 2, hstepB = (size_t)HALF * LDB * 2;
    constexpr size_t tstepA = 2 * hstepA, tstepB = 2 * hstepB;
    const unsigned ldsw = (unsigned)wid * 1024u;
    const int aoff = lds_byte(wr * 64 + fr, fq * 8), boff = lds_byte(wc * 32 + fr, fq * 8);
#define PG8_SA(b, h) (((b) * 2 + (h)) * HTB)
#define PG8_SB(b, h) ((4 + (b) * 2 + (h)) * HTB)
#define PG8_STAGE(bufoff, gbase, voff) do { _Pragma("unroll") for (int _i = 0; _i < 2; ++_i) \
        __builtin_amdgcn_global_load_lds((const unsigned*)((const char*)(gbase) + (voff)[_i]), (PG8_LAS unsigned*)(lds + (bufoff) + ldsw + _i * 8192), 16, 0, 0); } while (0)
#define PG8_LDA(dst, b, h) do { _Pragma("unroll") for (int m = 0; m < 4; ++m) _Pragma("unroll") for (int k = 0; k < 2; ++k) dst[m][k] = *(const PG8_LAS bf16x8*)(lds + PG8_SA(b, h) + aoff + m * 2048 + k * 1024); } while (0)
#define PG8_LDB(dst, b, h) do { _Pragma("unroll") for (int n = 0; n < 2; ++n) _Pragma("unroll") for (int k = 0; k < 2; ++k) dst[n][k] = *(const PG8_LAS bf16x8*)(lds + PG8_SB(b, h) + boff + n * 2048 + k * 1024); } while (0)
#define PG8_MMA(ai, bj, At, Bt) do { __builtin_amdgcn_s_setprio(1); _Pragma("unroll") for (int m = 0; m < 4; ++m) _Pragma("unroll") for (int n = 0; n < 2; ++n) _Pragma("unroll") for (int k = 0; k < 2; ++k) \
        acc[ai][bj][m][n] = __builtin_amdgcn_mfma_f32_16x16x32_bf16(Bt[n][k], At[m][k], acc[ai][bj][m][n], 0, 0, 0); __builtin_amdgcn_s_setprio(0); } while (0)
#define PG8_WAIT_V(n) asm volatile("s_waitcnt vmcnt(" #n ")" ::: "memory")
#define PG8_WAIT_L(n) asm volatile("s_waitcnt lgkmcnt(" #n ")" ::: "memory")
#define PG8_BAR __builtin_amdgcn_s_barrier()
#define PG8_SCHED __builtin_amdgcn_sched_barrier(0)
    Unit cur, nxt; int ui = 0;
    if (!S.next(0, cur)) return;
    f32x4 acc[2][2][4][2];
#pragma unroll
    for (int a = 0; a < 2; ++a)
#pragma unroll
        for (int b = 0; b < 2; ++b)
#pragma unroll
            for (int m = 0; m < 4; ++m)
#pragma unroll
                for (int n = 0; n < 2; ++n) acc[a][b][m][n] = (f32x4){0.f, 0.f, 0.f, 0.f};
    bf16x8 At[4][2], B0[2][2], B1[2][2];
    const char* cA = (const char*)g.A + (size_t)cur.pm * tstepA + (cur.pn >= g.a_split_pn ? (size_t)g.a_split_off * 2 : (size_t)0); const char* cB = (const char*)g.Bt + (size_t)cur.pn * tstepB;
    S.a_ready(cur);
    if constexpr (SP2) {
        PG8_STAGE(PG8_SB(0, 0), cB, voffB); PG8_STAGE(PG8_SB(0, 1), cB + hstepB, voffB); PG8_STAGE(PG8_SA(0, 0), cA, voffA); PG8_STAGE(PG8_SA(0, 1), cA + hstepA, voffA);
        if (wr == 1) PG8_BAR;
        PG8_WAIT_V(2); PG8_BAR;
        PG8_STAGE(PG8_SB(1, 0), cB + kstep, voffB); PG8_STAGE(PG8_SA(1, 0), cA + kstep, voffA); PG8_STAGE(PG8_SB(1, 1), cB + hstepB + kstep, voffB);
        PG8_WAIT_V(6); PG8_BAR;
    } else {
        PG8_STAGE(PG8_SB(0, 0), cB, voffB); PG8_STAGE(PG8_SA(0, 0), cA, voffA); PG8_STAGE(PG8_SB(0, 1), cB + hstepB, voffB); PG8_STAGE(PG8_SA(0, 1), cA + hstepA, voffA);
        if (wr == 1) PG8_BAR;
        PG8_WAIT_V(4); PG8_BAR;
        PG8_STAGE(PG8_SB(1, 0), cB + kstep, voffB); PG8_STAGE(PG8_SA(1, 0), cA + kstep, voffA); PG8_STAGE(PG8_SB(1, 1), cB + hstepB + kstep, voffB);
        PG8_WAIT_V(6); PG8_BAR;
    }
    for (;;) {
        const bool has_next = S.next(ui + 1, nxt);
        const char* nA = has_next ? (const char*)g.A + (size_t)nxt.pm * tstepA + (nxt.pn >= g.a_split_pn ? (size_t)g.a_split_off * 2 : (size_t)0) : cA; const char* nB = has_next ? (const char*)g.Bt + (size_t)nxt.pn * tstepB : cB;
        for (int t = 0; t < nt; t += 2) {
            const bool last = (t == nt - 2);
            const char* a1 = cA + (size_t)(t + 1) * kstep;
            const char* a2 = last ? nA : cA + (size_t)(t + 2) * kstep; const char* b2 = last ? nB : cB + (size_t)(t + 2) * kstep;
            const char* a3 = a2 + kstep; const char* b3 = b2 + kstep;
            if (last && has_next) S.a_ready(nxt);
            if constexpr (SP2) {
            PG8_LDB(B0, 0, 0); PG8_LDB(B1, 0, 1); PG8_SCHED; PG8_LDA(At, 0, 0); PG8_STAGE(PG8_SA(1, 1), a1 + hstepA, voffA);
            PG8_WAIT_V(8); PG8_WAIT_L(0); PG8_BAR; PG8_MMA(0, 0, At, B0); PG8_MMA(0, 1, At, B1); PG8_BAR; PG8_SCHED;
            PG8_LDA(At, 0, 1); PG8_STAGE(PG8_SB(0, 0), b2, voffB); PG8_STAGE(PG8_SB(0, 1), b2 + hstepB, voffB); PG8_STAGE(PG8_SA(0, 0), a2, voffA);
            PG8_WAIT_V(8); PG8_WAIT_L(0); PG8_BAR; PG8_MMA(1, 0, At, B0); PG8_MMA(1, 1, At, B1); PG8_BAR; PG8_SCHED;
            PG8_LDB(B0, 1, 0); PG8_LDB(B1, 1, 1); PG8_SCHED; PG8_LDA(At, 1, 0); PG8_STAGE(PG8_SA(0, 1), a2 + hstepA, voffA);
            PG8_WAIT_V(8); PG8_WAIT_L(0); PG8_BAR; PG8_MMA(0, 0, At, B0); PG8_MMA(0, 1, At, B1); PG8_BAR; PG8_SCHED;
            PG8_LDA(At, 1, 1); PG8_STAGE(PG8_SB(1, 0), b3, voffB); PG8_STAGE(PG8_SB(1, 1), b3 + hstepB, voffB); PG8_STAGE(PG8_SA(1, 0), a3, voffA);
            PG8_WAIT_V(8); PG8_WAIT_L(0); PG8_BAR; PG8_MMA(1, 0, At, B0); PG8_MMA(1, 1, At, B1); PG8_BAR; PG8_SCHED;
            } else {
            PG8_LDB(B0, 0, 0); PG8_SCHED; PG8_LDA(At, 0, 0); PG8_STAGE(PG8_SA(1, 1), a1 + hstepA, voffA);
            PG8_WAIT_L(8); PG8_BAR; PG8_WAIT_L(0); PG8_MMA(0, 0, At, B0); PG8_BAR; PG8_SCHED;
            PG8_LDB(B1, 0, 1); PG8_STAGE(PG8_SB(0, 0), b2, voffB);
            PG8_BAR; PG8_WAIT_L(0); PG8_MMA(0, 1, At, B1); PG8_BAR;
            PG8_LDA(At, 0, 1); PG8_STAGE(PG8_SA(0, 0), a2, voffA);
            PG8_BAR; PG8_WAIT_L(0); PG8_MMA(1, 0, At, B0); PG8_BAR; PG8_SCHED;
            PG8_STAGE(PG8_SB(0, 1), b2 + hstepB, voffB);
            PG8_WAIT_V(6); PG8_BAR; PG8_MMA(1, 1, At, B1); PG8_BAR;
            PG8_LDB(B0, 1, 0); PG8_SCHED; PG8_LDA(At, 1, 0); PG8_STAGE(PG8_SA(0, 1), a2 + hstepA, voffA);
            PG8_WAIT_L(8); PG8_BAR; PG8_WAIT_L(0); PG8_MMA(0, 0, At, B0); PG8_BAR; PG8_SCHED;
            PG8_LDB(B1, 1, 1); PG8_STAGE(PG8_SB(1, 0), b3, voffB);
            PG8_BAR; PG8_WAIT_L(0); PG8_MMA(0, 1, At, B1); PG8_BAR;
            PG8_LDA(At, 1, 1); PG8_STAGE(PG8_SA(1, 0), a3, voffA);
            PG8_BAR; PG8_WAIT_L(0); PG8_MMA(1, 0, At, B0); PG8_BAR; PG8_SCHED;
            PG8_STAGE(PG8_SB(1, 1), b3 + hstepB, voffB);
            PG8_WAIT_V(6); PG8_BAR; PG8_MMA(1, 1, At, B1); PG8_BAR;
            }
        }
        if constexpr (ALIGN_EPI) { if (wr == 0) PG8_BAR; }
        if constexpr (!Epi::AFTER_DRAIN) { E(acc, cur, wr, wc, fr, fq); S.done(cur); }
        if (!has_next) break;
#pragma unroll
        for (int a = 0; a < 2; ++a)
#pragma unroll
            for (int b = 0; b < 2; ++b)
#pragma unroll
                for (int m = 0; m < 4; ++m)
#pragma unroll
                    for (int n = 0; n < 2; ++n) acc[a][b][m][n] = (f32x4){0.f, 0.f, 0.f, 0.f};
        cur = nxt; cA = nA; cB = nB; ++ui;
        if constexpr (ALIGN_EPI) { if (wr == 1) PG8_BAR; }
    }
    PG8_WAIT_V(0);
    if constexpr (!ALIGN_EPI) { if (wr == 0) PG8_BAR; }
    PG8_BAR;
    if constexpr (Epi::AFTER_DRAIN) { E.fused(acc, cur, wr, wc, fr, fq, lds, wid, lane); S.done(cur); }
#undef PG8_SA
#undef PG8_SB
#undef PG8_STAGE
#undef PG8_LDA
#undef PG8_LDB
#undef PG8_MMA
#undef PG8_WAIT_V
#undef PG8_WAIT_L
#undef PG8_BAR
#undef PG8_SCHED
}
}

#define LAS __attribute__((address_space(3)))
typedef unsigned short bf16;
typedef short bf16x8 __attribute__((ext_vector_type(8)));
typedef float f32x4 __attribute__((ext_vector_type(4)));
typedef float f32x16 __attribute__((ext_vector_type(16)));
typedef unsigned u32x4 __attribute__((ext_vector_type(4)));
typedef unsigned u32x2 __attribute__((ext_vector_type(2)));
constexpr int NB = 4, SEQ = 4096, DM = 1024, MT = NB * SEQ;
constexpr int NPROJ = 5640, NPROJ_PAD = 5888, DFF = 2816, NUP = 5632;
constexpr int C_QA = 0, C_KA = 512, C_VA = 1024, C_QM = 1536, C_KM = 2048, C_VM = 2560, C_OM = 3072, C_GA = 3584, C_GM = 4608, C_I = 5632, C_F = 5636;
constexpr float EPS = 1e-6f;
constexpr float QSCALE = 0.125f * 1.4426950408889634f;
constexpr float NEGF = -1e30f;
constexpr size_t MiB = 1u << 20;
constexpr size_t WS_RSS1 = 0, WS_RSS2 = 64 * 1024, WS_GA = 128 * 1024, WS_GB = 384 * 1024, WS_ST = 640 * 1024, WS_MC = 648 * 1024, WS_CSC = 652 * 1024,
                 WS_KSUM = 1 * MiB, WS_NL = 2 * MiB, WS_BAR = 3 * MiB;
constexpr size_t WS_WIN = 4 * MiB, WS_WUP = WS_WIN + 23 * MiB / 2, WS_WDN = WS_WUP + 11 * MiB, WS_WO = 32 * MiB, WS_WBA = 34 * MiB, WS_WBM = 35 * MiB;
constexpr size_t WS_H = 36 * MiB;
constexpr size_t WS_QM = WS_H, WS_KM = WS_H + 16 * MiB, WS_MRG = WS_H, WS_U = WS_H;
constexpr size_t WS_PROJ = 68 * MiB;
constexpr size_t WS_G = 124 * MiB;
constexpr size_t WS_X1B = 224 * MiB;
constexpr size_t WS_END = 256 * MiB;
constexpr int LDS_BYTES = 147456;

__device__ __forceinline__ float bf2f(unsigned short v) { return __uint_as_float((unsigned)v << 16); }
__device__ __forceinline__ unsigned short f2bf(float f) { unsigned u = __float_as_uint(f); return (unsigned short)((u + 0x7fffu + ((u >> 16) & 1u)) >> 16); }
__device__ __forceinline__ unsigned pk2(float lo, float hi) { return (unsigned)f2bf(lo) | ((unsigned)f2bf(hi) << 16); }
__device__ __forceinline__ float bflo(unsigned w) { return __uint_as_float(w << 16); }
__device__ __forceinline__ float bfhi(unsigned w) { return __uint_as_float(w & 0xffff0000u); }
__device__ __forceinline__ float sigmoidf_(float v) { return 1.0f / (1.0f + __expf(-v)); }
__device__ __forceinline__ float siluf_(float v) { return v / (1.0f + __expf(-v)); }
__device__ __forceinline__ float red32_sum(float v) { v += __shfl_xor(v, 1); v += __shfl_xor(v, 2); v += __shfl_xor(v, 4); v += __shfl_xor(v, 8); v += __shfl_xor(v, 16); return v; }
__device__ __forceinline__ float wave_sum(float v) {
#pragma unroll
    for (int o = 1; o < 64; o <<= 1) v += __shfl_xor(v, o);
    return v;
}
__device__ __forceinline__ float wave_max(float v) {
#pragma unroll
    for (int o = 1; o < 64; o <<= 1) v = fmaxf(v, __shfl_xor(v, o));
    return v;
}
__device__ __forceinline__ f32x16 mma32(f32x16 acc, const LAS bf16* A, int lda, const LAS bf16* B, int ldb, int ksteps, int lane) {
    const int r = lane & 31, h = lane >> 5;
    const LAS bf16* ap = A + r * lda + 8 * h; const LAS bf16* bp = B + r * ldb + 8 * h;
    for (int ks = 0; ks < ksteps; ++ks) {
        const bf16x8 a = *(const LAS bf16x8*)(ap + 16 * ks), b = *(const LAS bf16x8*)(bp + 16 * ks);
        acc = __builtin_amdgcn_mfma_f32_32x32x16_bf16(a, b, acc, 0, 0, 0);
    }
    return acc;
}
typedef float f32x2_t __attribute__((ext_vector_type(2))); typedef __bf16 bf16x2_t __attribute__((ext_vector_type(2)));
__device__ __forceinline__ unsigned cvtpk(float lo, float hi) { f32x2_t v = {lo, hi}; bf16x2_t b = __builtin_convertvector(v, bf16x2_t); return __builtin_bit_cast(unsigned, b); }
typedef short v4i16_t __attribute__((ext_vector_type(4)));
__device__ __forceinline__ u32x2 lds_tr(const LAS bf16* p) { return __builtin_bit_cast(u32x2, __builtin_amdgcn_ds_read_tr16_b64_v4i16((LAS v4i16_t*)p)); }
__device__ __forceinline__ int crow(int i, int h) { return (i & 3) + 8 * (i >> 2) + 4 * h; }
using pg8::Unit; using pg8::cvt_pk_bf16;
typedef const f32x4 (&AccRef)[2][2][4][2];
__device__ __forceinline__ u32x4 pack8(f32x4 a, f32x4 b) { u32x4 w; w.x = cvt_pk_bf16(a[0], a[1]); w.y = cvt_pk_bf16(a[2], a[3]); w.z = cvt_pk_bf16(b[0], b[1]); w.w = cvt_pk_bf16(b[2], b[3]); return w; }
__device__ __forceinline__ void unpack8(u32x4 w, f32x4& a, f32x4& b) { a = (f32x4){bflo(w.x), bfhi(w.x), bflo(w.y), bfhi(w.y)}; b = (f32x4){bflo(w.z), bfhi(w.z), bflo(w.w), bfhi(w.w)}; }
__device__ __forceinline__ f32x4 sig4(f32x4 v) { return (f32x4){sigmoidf_(v[0]), sigmoidf_(v[1]), sigmoidf_(v[2]), sigmoidf_(v[3])}; }
#define EPI_LOOP_BEGIN  _Pragma("unroll") for (int ai = 0; ai < 2; ++ai) _Pragma("unroll") for (int m = 0; m < 4; ++m) { const int row = u.pm * 256 + ai * 128 + wr * 64 + m * 16 + fr;
#define EPI_COL(bj) (u.pn * 256 + (bj) * 128 + wc * 32 + 8 * fq)
struct EpiProj { static constexpr bool PERM = true, AFTER_DRAIN = false; bf16* O;
    __device__ __forceinline__ void operator()(AccRef acc, const Unit& u, int wr, int wc, int fr, int fq) const {
        EPI_LOOP_BEGIN
#pragma unroll
            for (int bj = 0; bj < 2; ++bj) { const int col = EPI_COL(bj); if (col < NPROJ) *(u32x4*)(O + (size_t)row * NPROJ + col) = pack8(acc[ai][bj][m][0], acc[ai][bj][m][1]); }
        }
    }
};
template <bool ADD> struct EpiGate { static constexpr bool PERM = true, AFTER_DRAIN = false; const bf16* P; bf16* T; int gcol0;
    __device__ __forceinline__ void operator()(AccRef acc, const Unit& u, int wr, int wc, int fr, int fq) const {
        EPI_LOOP_BEGIN
#pragma unroll
            for (int bj = 0; bj < 2; ++bj) { const int col = EPI_COL(bj);
                const u32x4 gw = *(const u32x4*)(P + (size_t)row * NPROJ + gcol0 + col); f32x4 g0, g1; unpack8(gw, g0, g1);
                f32x4 v0 = acc[ai][bj][m][0] * sig4(g0), v1 = acc[ai][bj][m][1] * sig4(g1);
                bf16* tp = T + (size_t)row * DM + col;
                if (ADD) { f32x4 t0, t1; unpack8(*(const u32x4*)tp, t0, t1); v0 += t0; v1 += t1; }
                *(u32x4*)tp = pack8(v0, v1); }
        }
    }
};

struct PairOrder { int G, vc;
    __device__ void init(int G_, int c) { G = G_; vc = (G_ % 8 == 0) ? (c % 8) * (G_ / 8) + c / 8 : c; }
    __device__ bool next(int i, Unit& u) const { const int p = vc + (i >> 1) * G; if (p >= 256) return false; u.pm = p >> 2; u.pn = (p & 3) + 4 * (i & 1); return true; }
    __device__ __forceinline__ void a_ready(const Unit&) const {}
    __device__ __forceinline__ void done(const Unit&) const {}
};
struct EpiGate2 { static constexpr bool PERM = true, AFTER_DRAIN = false; const bf16* P; bf16* T;
    __device__ __forceinline__ void operator()(AccRef acc, const Unit& u0, int wr, int wc, int fr, int fq) const {
        const bool second = u0.pn >= 4; Unit u; u.pm = u0.pm; u.pn = u0.pn & 3; const int gcol0 = second ? C_GM : C_GA;
#pragma unroll
        for (int ai = 0; ai < 2; ++ai) {
            u32x4 gw[4][2], tw[4][2];
#pragma unroll
            for (int m = 0; m < 4; ++m)
#pragma unroll
                for (int bj = 0; bj < 2; ++bj) { const int row = u.pm * 256 + ai * 128 + wr * 64 + m * 16 + fr, col = EPI_COL(bj);
                    gw[m][bj] = *(const u32x4*)(P + (size_t)row * NPROJ + gcol0 + col);
                    if (second) tw[m][bj] = *(const u32x4*)(T + (size_t)row * DM + col); }
            asm volatile("" ::: "memory");
#pragma unroll
            for (int m = 0; m < 4; ++m)
#pragma unroll
                for (int bj = 0; bj < 2; ++bj) { const int row = u.pm * 256 + ai * 128 + wr * 64 + m * 16 + fr, col = EPI_COL(bj);
                    f32x4 g0, g1; unpack8(gw[m][bj], g0, g1);
                    f32x4 v0 = acc[ai][bj][m][0] * sig4(g0), v1 = acc[ai][bj][m][1] * sig4(g1);
                    if (second) { f32x4 t0, t1; unpack8(tw[m][bj], t0, t1); v0 += t0; v1 += t1; }
                    *(u32x4*)(T + (size_t)row * DM + col) = pack8(v0, v1); }
        }
    }
};
struct EpiRes1 { static constexpr bool PERM = true, AFTER_DRAIN = false; const float* x; float* x1; bf16* x1b; float* rss;
    __device__ __forceinline__ void operator()(AccRef acc, const Unit& u, int wr, int wc, int fr, int fq) const {
#pragma unroll
        for (int ai = 0; ai < 2; ++ai)
#pragma unroll
        for (int mg = 0; mg < 4; mg += 2) {
            f32x4 xv[4][2][2];
#pragma unroll
            for (int m = mg; m < mg + 2; ++m)
#pragma unroll
                for (int bj = 0; bj < 2; ++bj) { const int row = u.pm * 256 + ai * 128 + wr * 64 + m * 16 + fr; const size_t off = (size_t)row * DM + EPI_COL(bj);
                    xv[m][bj][0] = *(const f32x4*)(x + off); xv[m][bj][1] = *(const f32x4*)(x + off + 4); }
            asm volatile("" ::: "memory");
#pragma unroll
            for (int m = mg; m < mg + 2; ++m) { const int row = u.pm * 256 + ai * 128 + wr * 64 + m * 16 + fr; float ss = 0.f;
#pragma unroll
                for (int bj = 0; bj < 2; ++bj) { const size_t off = (size_t)row * DM + EPI_COL(bj);
                    const f32x4 v0 = acc[ai][bj][m][0] + xv[m][bj][0], v1 = acc[ai][bj][m][1] + xv[m][bj][1];
                    *(f32x4*)(x1 + off) = v0; *(f32x4*)(x1 + off + 4) = v1; *(u32x4*)(x1b + off) = pack8(v0, v1);
                    ss += (v0[0] * v0[0] + v0[1] * v0[1]) + (v0[2] * v0[2] + v0[3] * v0[3]) + (v1[0] * v1[0] + v1[1] * v1[1]) + (v1[2] * v1[2] + v1[3] * v1[3]); }
                ss += __shfl_xor(ss, 16); ss += __shfl_xor(ss, 32);
                if (fq == 0) unsafeAtomicAdd(rss + row, ss); }
        }
    }
};
struct EpiUp { static constexpr bool PERM = true, AFTER_DRAIN = false; bf16* U; const float* rss;
    __device__ __forceinline__ void operator()(AccRef acc, const Unit& u, int wr, int wc, int fr, int fq) const {
        EPI_LOOP_BEGIN
            const float rs = rsqrtf(rss[row] * (1.0f / DM) + EPS);
#pragma unroll
            for (int bj = 0; bj < 2; ++bj) { const int col = EPI_COL(bj); *(u32x4*)(U + (size_t)row * NUP + col) = pack8(acc[ai][bj][m][0] * rs, acc[ai][bj][m][1] * rs); }
        }
    }
};
struct EpiRes2 { static constexpr bool PERM = true, AFTER_DRAIN = false; float* xio; float* rss;
    __device__ __forceinline__ void operator()(AccRef acc, const Unit& u, int wr, int wc, int fr, int fq) const {
#pragma unroll
        for (int ai = 0; ai < 2; ++ai)
#pragma unroll
        for (int mg = 0; mg < 4; mg += 2) {
            f32x4 xv[4][2][2];
#pragma unroll
            for (int m = mg; m < mg + 2; ++m)
#pragma unroll
                for (int bj = 0; bj < 2; ++bj) { const int row = u.pm * 256 + ai * 128 + wr * 64 + m * 16 + fr; const size_t off = (size_t)row * DM + EPI_COL(bj);
                    xv[m][bj][0] = *(const f32x4*)(xio + off); xv[m][bj][1] = *(const f32x4*)(xio + off + 4); }
            asm volatile("" ::: "memory");
#pragma unroll
            for (int m = mg; m < mg + 2; ++m) { const int row = u.pm * 256 + ai * 128 + wr * 64 + m * 16 + fr; float ss = 0.f;
#pragma unroll
                for (int bj = 0; bj < 2; ++bj) { const size_t off = (size_t)row * DM + EPI_COL(bj);
                    const f32x4 v0 = acc[ai][bj][m][0] + xv[m][bj][0], v1 = acc[ai][bj][m][1] + xv[m][bj][1];
                    *(f32x4*)(xio + off) = v0; *(f32x4*)(xio + off + 4) = v1;
                    ss += (v0[0] * v0[0] + v0[1] * v0[1]) + (v0[2] * v0[2] + v0[3] * v0[3]) + (v1[0] * v1[0] + v1[1] * v1[1]) + (v1[2] * v1[2] + v1[3] * v1[3]); }
                ss += __shfl_xor(ss, 16); ss += __shfl_xor(ss, 32);
                if (fq == 0) unsafeAtomicAdd(rss + row, ss); }
        }
    }
};
template <int MODE> __device__ __forceinline__ void transpose_item(const float* W, int K, int N, bf16* WT, LAS float* scr, int item, int lane, const float* gk) {
    const int nblk = (N + 31) / 32, kb = item / nblk, nb = item % nblk, k0 = 64 * kb, n0 = 32 * nb;
    float tv[32];
    { const int n = n0 + (lane & 31); const bool ok = n < N; const float* wp = W + (size_t)(k0 + (lane >> 5)) * N + (ok ? n : 0);
#pragma unroll
      for (int i = 0; i < 32; ++i) tv[i] = wp[(size_t)(2 * i) * N];
#pragma unroll
      for (int i = 0; i < 32; ++i) { const int kk = 2 * i + (lane >> 5); float v = ok ? tv[i] : 0.f; if (MODE == 2) v *= gk[k0 + kk]; scr[kk * 33 + (lane & 31)] = v; } }
    asm volatile("s_waitcnt lgkmcnt(0)" ::: "memory");
    const int c = lane & 7;
#pragma unroll
    for (int j = 0; j < 4; ++j) { const int nl = (lane >> 3) + 8 * j, n = n0 + nl; const LAS float* s = scr + (8 * c) * 33 + nl;
        if (n < N) { int dn = n; if (MODE == 1) dn = (n < 3584) ? n : ((n < 3592) ? (C_I + (n - 3584)) : (n - 8));
            u32x4 o; o.x = pk2(s[0 * 33], s[1 * 33]); o.y = pk2(s[2 * 33], s[3 * 33]); o.z = pk2(s[4 * 33], s[5 * 33]); o.w = pk2(s[6 * 33], s[7 * 33]);
            *(u32x4*)(WT + (size_t)dn * K + k0 + 8 * c) = o; } }
    asm volatile("s_waitcnt lgkmcnt(0)" ::: "memory");
}
struct P0Args { const float *x, *g1, *w_in, *wba, *wbm, *wo, *g2, *wup, *wdn; bf16 *WinT, *WbaT, *WbmT, *WoT, *WupT, *WdnT, *H; float *rss1, *rss2; };
__device__ __forceinline__ void p0_prologue(const P0Args& a, LAS unsigned char* lds, int tid, int G) {
    const int lane = tid & 63, wave = tid >> 6;
    LAS float* scr = (LAS float*)(lds + wave * 16384);
    const int gw = blockIdx.x * 8 + wave, NGW = G * 8;
    constexpr int I_IN = (DM / 64) * ((NPROJ + 31) / 32), I_BA = (512 / 64) * (DM / 32), I_O = (DM / 64) * (DM / 32), I_UP = (DM / 64) * (NUP / 32), I_DN = (DFF / 64) * (DM / 32);
    constexpr int NITEMS = I_IN + 2 * I_BA + I_O + I_UP + I_DN;
    for (int it = gw; it < NITEMS; it += NGW) {
        int r = it;
        if (r < I_IN) { transpose_item<1>(a.w_in, DM, NPROJ, a.WinT, scr, r, lane, nullptr); continue; } r -= I_IN;
        if (r < I_BA) { transpose_item<0>(a.wba, 512, DM, a.WbaT, scr, r, lane, nullptr); continue; } r -= I_BA;
        if (r < I_BA) { transpose_item<0>(a.wbm, 512, DM, a.WbmT, scr, r, lane, nullptr); continue; } r -= I_BA;
        if (r < I_O) { transpose_item<0>(a.wo, DM, DM, a.WoT, scr, r, lane, nullptr); continue; } r -= I_O;
        if (r < I_UP) { transpose_item<2>(a.wup, DM, NUP, a.WupT, scr, r, lane, a.g2); continue; } r -= I_UP;
        transpose_item<0>(a.wdn, DFF, DM, a.WdnT, scr, r, lane, nullptr);
    }
    for (int m = gw; m < MT; m += NGW) {
        const f32x4* xr = (const f32x4*)(a.x + (size_t)m * DM) + lane; f32x4 v[4]; float s = 0.f;
#pragma unroll
        for (int j = 0; j < 4; ++j) { v[j] = xr[64 * j]; s += (v[j][0] * v[j][0] + v[j][1] * v[j][1]) + (v[j][2] * v[j][2] + v[j][3] * v[j][3]); }
        const float rstd = rsqrtf(wave_sum(s) * (1.0f / DM) + EPS);
        u32x2* o8 = (u32x2*)(a.H + (size_t)m * DM) + lane;
#pragma unroll
        for (int j = 0; j < 4; ++j) { const f32x4 g = *((const f32x4*)a.g1 + lane + 64 * j); u32x2 w; w.x = pk2(v[j][0] * rstd * g[0], v[j][1] * rstd * g[1]); w.y = pk2(v[j][2] * rstd * g[2], v[j][3] * rstd * g[3]); o8[64 * j] = w; }
    }
    for (int i = blockIdx.x * 512 + tid; i < MT; i += G * 512) { a.rss1[i] = 0.f; a.rss2[i] = 0.f; }
}

struct P2Args { bf16* P; const int* pos; const float *conv_m, *i_bias, *f_bias; bf16 *QM, *KM; float *GA, *GB, *ST, *KSUM; };
__device__ __forceinline__ void p2_unit(const P2Args& a, LAS unsigned char* lds, int tid, int cu) {
    const int lane = tid & 63, wave = tid >> 6;
    const int b = cu >> 6, c = cu & 63, t0 = b * SEQ + c * 64;
    LAS float* cs = (LAS float*)lds;
    LAS float* sn = cs + 2048;
    LAS float* ks2 = sn + 2048;
    for (int e = tid; e < 2048; e += 512) { const int tok = e >> 5, i = e & 31; const float invf = powf(10000.0f, -(float)i * (1.0f / 32.0f));
        const float ang = (float)a.pos[t0 + tok] * invf; float sv, cv; sincosf(ang, &sv, &cv); cs[e] = cv; sn[e] = sv; }
    __syncthreads();
    {
        const int cgp = tid & 63, isk = cgp >> 5, hh = (cgp >> 2) & 7, ig = cgp & 3; const int col = (isk ? C_KA : C_QA) + hh * 64 + ig * 8; const float sc = isk ? 1.0f : QSCALE;
        float s1[8], s2[8];
#pragma unroll
        for (int e = 0; e < 8; ++e) { s1[e] = 0.f; s2[e] = 0.f; }
        for (int kb = 0; kb < 8; kb += 4) {
        u32x4 lo[4], hi[4];
#pragma unroll
        for (int k = 0; k < 4; ++k) { const bf16* p = a.P + (size_t)(t0 + wave + 8 * (kb + k)) * NPROJ + col; lo[k] = *(const u32x4*)p; hi[k] = *(const u32x4*)(p + 32); }
#pragma unroll
        for (int k = 0; k < 4; ++k) { const int tok = wave + 8 * (kb + k); f32x4 a0, a1, b0, b1; unpack8(lo[k], a0, a1); unpack8(hi[k], b0, b1);
            float v1[8] = {a0[0], a0[1], a0[2], a0[3], a1[0], a1[1], a1[2], a1[3]}, v2[8] = {b0[0], b0[1], b0[2], b0[3], b1[0], b1[1], b1[2], b1[3]}, o1[8], o2[8];
#pragma unroll
            for (int e = 0; e < 8; ++e) { const float cv = cs[tok * 32 + ig * 8 + e], sv = sn[tok * 32 + ig * 8 + e]; o1[e] = v1[e] * cv - v2[e] * sv; o2[e] = v2[e] * cv + v1[e] * sv; s1[e] += o1[e]; s2[e] += o2[e]; }
            bf16* p = a.P + (size_t)(t0 + tok) * NPROJ + col; u32x4 w1, w2;
            w1.x = pk2(o1[0] * sc, o1[1] * sc); w1.y = pk2(o1[2] * sc, o1[3] * sc); w1.z = pk2(o1[4] * sc, o1[5] * sc); w1.w = pk2(o1[6] * sc, o1[7] * sc);
            w2.x = pk2(o2[0] * sc, o2[1] * sc); w2.y = pk2(o2[2] * sc, o2[3] * sc); w2.z = pk2(o2[4] * sc, o2[5] * sc); w2.w = pk2(o2[6] * sc, o2[7] * sc);
            *(u32x4*)p = w1; *(u32x4*)(p + 32) = w2; }
        }
        if (isk) {
#pragma unroll
            for (int e = 0; e < 8; ++e) { ks2[wave * 512 + (cgp & 31) * 16 + e] = s1[e]; ks2[wave * 512 + (cgp & 31) * 16 + 8 + e] = s2[e]; } }
    }
    __syncthreads();
    {
        float t = 0.f;
#pragma unroll
        for (int w = 0; w < 8; ++w) t += ks2[w * 512 + tid];
        const int g = tid >> 4, e16 = tid & 15, hh = g >> 2, ig = g & 3, d = (e16 >> 3) * 32 + ig * 8 + (e16 & 7);
        a.KSUM[((size_t)(b * 8 + hh) * 64 + c) * 64 + d] = t;
    }
    {
        const int cg8 = (tid & 127) * 8; const bool isk = cg8 >= 512; const int col = (isk ? C_KM + cg8 - 512 : C_QM + cg8);
        f32x4 w[4][2];
#pragma unroll
        for (int j = 0; j < 4; ++j) { w[j][0] = *(const f32x4*)(a.conv_m + j * 1024 + cg8); w[j][1] = *(const f32x4*)(a.conv_m + j * 1024 + cg8 + 4); }
        const float osc = isk ? 0.08838834764831845f : 1.0f;
        for (int rr = 0; rr < 2; ++rr) { const int run = (tid >> 7) * 2 + rr, tr0 = run * 8; const bool havehalo = (c > 0) || (run > 0);
            const bf16* src = a.P + (size_t)(t0 + tr0 - 3) * NPROJ + col; u32x4 xr[11];
#pragma unroll
            for (int k = 0; k < 11; ++k) xr[k] = (k >= 3 || havehalo) ? *(const u32x4*)(src + (size_t)k * NPROJ) : (u32x4){0u, 0u, 0u, 0u};
            bf16* dst = (isk ? a.KM + (cg8 - 512) : a.QM + cg8) + (size_t)(t0 + tr0) * 512;
            f32x4 x0[2], x1[2], x2[2]; unpack8(xr[0], x0[0], x0[1]); unpack8(xr[1], x1[0], x1[1]); unpack8(xr[2], x2[0], x2[1]);
#pragma unroll
            for (int k = 0; k < 8; ++k) { f32x4 x3[2]; unpack8(xr[k + 3], x3[0], x3[1]); f32x4 o[2];
#pragma unroll
                for (int e = 0; e < 2; ++e) { const f32x4 y = w[0][e] * x0[e] + w[1][e] * x1[e] + w[2][e] * x2[e] + w[3][e] * x3[e];
                    o[e] = (f32x4){siluf_(y[0]) * osc, siluf_(y[1]) * osc, siluf_(y[2]) * osc, siluf_(y[3]) * osc}; x0[e] = x1[e]; x1[e] = x2[e]; x2[e] = x3[e]; }
                *(u32x4*)(dst + (size_t)k * 512) = pack8(o[0], o[1]); } }
    }
    if (wave < 4) {
        const int hh = wave; const size_t prow = (size_t)(t0 + lane) * NPROJ;
        const float av = bf2f(a.P[prow + C_I + hh]) + a.i_bias[hh]; const float fp = bf2f(a.P[prow + C_F + hh]) + a.f_bias[hh];
        const float lf = fminf(fp, 0.f) - log1pf(__expf(-fabsf(fp)));
        float bc = lf;
#pragma unroll
        for (int o = 1; o < 64; o <<= 1) { const float t = __shfl_up(bc, o); if (lane >= o) bc += t; }
        const float blast = __shfl(bc, 63); const float md = wave_max(blast - bc + av);
        const size_t gi = (size_t)(b * 4 + hh) * SEQ + c * 64 + lane; a.GA[gi] = av; a.GB[gi] = bc;
        if (lane == 0) { float* st = a.ST + ((size_t)(b * 4 + hh) * 64 + c) * 2; st[0] = blast; st[1] = md; }
    }
    __syncthreads();
}
struct P3Args { const bf16 *P, *KM; const float *GA, *GB, *ST; bf16* CT; float *NL, *MC, *CSC; };
__device__ __forceinline__ void p3_unit(const P3Args& a, LAS unsigned char* lds, int tid, int un) {
    const int lane = tid & 63, wave = tid >> 6;
    const int bh = un >> 6, c = un & 63, b = bh >> 2, hh = bh & 3, t0 = b * SEQ + c * 64;
    LAS bf16* KT = (LAS bf16*)lds;
    LAS bf16* VT = KT + 128 * 72;
    LAS float* wk = (LAS float*)(VT + 128 * 72);
    LAS float* msc = wk + 64;
    if (wave == 0) {
        const float* st = a.ST + (size_t)bh * 128; const float bl = st[2 * lane], md = st[2 * lane + 1];
        float m = 0.f;
        for (int j = 0; j < c; ++j) m = fmaxf(__shfl(bl, j) + m, __shfl(md, j));
        const float blc = __shfl(bl, c), mdc = __shfl(md, c); const float mnew = fmaxf(blc + m, mdc);
        const size_t gi = (size_t)bh * SEQ + c * 64 + lane;
        wk[lane] = __expf(blc - a.GB[gi] + a.GA[gi] - mnew);
        if (lane == 0) { a.MC[un] = m; a.CSC[un] = __expf(blc + m - mnew); }
    }
    __syncthreads();
#pragma unroll
    for (int k = 0; k < 2; ++k) { const int q = tid + 512 * k, s = q >> 4, dc = (q & 15) * 8;
        const u32x4 kw = *(const u32x4*)(a.KM + (size_t)(t0 + s) * 512 + hh * 128 + dc);
        const u32x4 vw = *(const u32x4*)(a.P + (size_t)(t0 + s) * NPROJ + C_VM + hh * 128 + dc);
        const float w = wk[s]; f32x4 k0, k1; unpack8(kw, k0, k1);
#pragma unroll
        for (int e = 0; e < 4; ++e) { KT[(dc + e) * 72 + s] = f2bf(k0[e] * w); KT[(dc + 4 + e) * 72 + s] = f2bf(k1[e] * w); }
        const unsigned vv[4] = {vw.x, vw.y, vw.z, vw.w};
#pragma unroll
        for (int e = 0; e < 4; ++e) { VT[(dc + 2 * e) * 72 + s] = (bf16)(vv[e] & 0xffffu); VT[(dc + 2 * e + 1) * 72 + s] = (bf16)(vv[e] >> 16); } }
    __syncthreads();
    if (tid < 128) { float s = 0.f; for (int j = 0; j < 64; ++j) s += bf2f(KT[tid * 72 + j]); a.NL[(size_t)un * 128 + tid] = s; }
    {
        const int vt = wave >> 1, r = lane & 31, h = lane >> 5;
#pragma unroll
        for (int dd = 0; dd < 2; ++dd) { const int dt = 2 * (wave & 1) + dd; f32x16 acc; for (int i = 0; i < 16; ++i) acc[i] = 0.f;
            acc = mma32(acc, VT + 32 * vt * 72, 72, KT + 32 * dt * 72, 72, 4, lane);
            bf16* o = a.CT + (size_t)un * 16384 + 32 * dt + r;
#pragma unroll
            for (int i = 0; i < 16; ++i) o[(size_t)(32 * vt + crow(i, h)) * 128] = f2bf(acc[i]); }
    }
    __syncthreads();
}
__device__ __forceinline__ void p4_scan(bf16* CT, float* NL, const float* CSC, int tid, int G) {
    const int gt = blockIdx.x * 512 + tid, NT = G * 512;
    for (int it = gt; it < 16 * 4096; it += NT) { const int bh = it >> 12, e4 = it & 4095;
        bf16* p = CT + (size_t)bh * 64 * 16384 + 4 * e4; const float* cs = CSC + bh * 64; float c0 = 0.f, c1 = 0.f, c2 = 0.f, c3 = 0.f;
        for (int cb = 0; cb < 64; cb += 16) { u32x2 lv[16]; bf16* pb = p + (size_t)cb * 16384;
#pragma unroll
            for (int c = 0; c < 16; ++c) lv[c] = *(const u32x2*)(pb + (size_t)c * 16384);
#pragma unroll
            for (int c = 0; c < 16; ++c) { const u32x2 l = lv[c]; u32x2 o; o.x = pk2(c0, c1); o.y = pk2(c2, c3); *(u32x2*)(pb + (size_t)c * 16384) = o;
                const float s = cs[cb + c]; c0 = s * c0 + bflo(l.x); c1 = s * c1 + bfhi(l.x); c2 = s * c2 + bflo(l.y); c3 = s * c3 + bfhi(l.y); } } }
    for (int it = gt; it < 16 * 128; it += NT) { const int bh = it >> 7, e = it & 127; float* p = NL + (size_t)bh * 64 * 128 + e; const float* cs = CSC + bh * 64; float n0 = 0.f;
        for (int c = 0; c < 64; ++c) { const float l = p[c * 128]; p[c * 128] = n0; n0 = cs[c] * n0 + l; } }
}
struct P5Args { bf16* P; const bf16 *QM, *KM; const float *GA, *GB; const bf16* CT; const float *NL, *MC, *ng; };
__device__ __forceinline__ void p5_unit(const P5Args& a, LAS unsigned char* lds, int tid, int un) {
    const int lane = tid & 63, wave = tid >> 6, r = lane & 31, h = lane >> 5;
    const int bh = un >> 6, c = un & 63, b = bh >> 2, hh = bh & 3, t0 = b * SEQ + c * 64;
    LAS bf16* Qs = (LAS bf16*)lds;
    LAS bf16* Ks = Qs + 64 * 136;
    LAS bf16* VT = Ks + 64 * 136;
    LAS bf16* Et = VT + 128 * 72;
    LAS bf16* Ps = Et + 128 * 136;
    LAS float* fa = (LAS float*)(Ps + 64 * 72);
    LAS float* fb = fa + 64;
    LAS float* fmt = fb + 64;
    LAS float* fwi = fmt + 64;
    LAS float* fqn = fwi + 64;
    LAS float* frs = fqn + 64;
    LAS float* fss = frs + 128;
    LAS float* fnp = fss + 256;
    const float mc = a.MC[un];
#pragma unroll
    for (int k = 0; k < 2; ++k) { const int q = tid + 512 * k, s = q >> 4, dc = (q & 15) * 8;
        *(LAS u32x4*)(Qs + s * 136 + dc) = *(const u32x4*)(a.QM + (size_t)(t0 + s) * 512 + hh * 128 + dc);
        *(LAS u32x4*)(Ks + s * 136 + dc) = *(const u32x4*)(a.KM + (size_t)(t0 + s) * 512 + hh * 128 + dc);
        const u32x4 vw = *(const u32x4*)(a.P + (size_t)(t0 + s) * NPROJ + C_VM + hh * 128 + dc);
        const unsigned vv[4] = {vw.x, vw.y, vw.z, vw.w};
#pragma unroll
        for (int e = 0; e < 4; ++e) { VT[(dc + 2 * e) * 72 + s] = (bf16)(vv[e] & 0xffffu); VT[(dc + 2 * e + 1) * 72 + s] = (bf16)(vv[e] >> 16); } }
#pragma unroll
    for (int k = 0; k < 4; ++k) { const int q = tid + 512 * k, v = q >> 4, dc = (q & 15) * 8; *(LAS u32x4*)(Et + v * 136 + dc) = *(const u32x4*)(a.CT + (size_t)un * 16384 + v * 128 + dc); }
    if (tid < 128) fnp[tid] = a.NL[(size_t)un * 128 + tid];
    if (tid < 64) { const size_t gi = (size_t)bh * SEQ + c * 64 + tid; fa[tid] = a.GA[gi]; fb[tid] = a.GB[gi]; }
    __syncthreads();
    {
        const int l = tid >> 3, d0 = (tid & 7) * 16; float qn = 0.f;
#pragma unroll
        for (int d = 0; d < 16; ++d) qn += bf2f(Qs[l * 136 + d0 + d]) * fnp[d0 + d];
        qn += __shfl_xor(qn, 1); qn += __shfl_xor(qn, 2); qn += __shfl_xor(qn, 4);
        if ((tid & 7) == 0) fqn[l] = qn; }
    if (wave == 0) { const int l = lane; float pm = fa[l] - fb[l];
#pragma unroll
        for (int o = 1; o < 64; o <<= 1) { const float t = __shfl_up(pm, o); if (lane >= o) pm = fmaxf(pm, t); }
        const float bl = fb[l], mt = fmaxf(bl + mc, bl + pm); fmt[l] = mt; fwi[l] = __expf(bl + mc - mt); }
    __syncthreads();
    if (wave < 4) {
        const int lt = wave & 1, st = wave >> 1; f32x16 acc; for (int i = 0; i < 16; ++i) acc[i] = 0.f;
        acc = mma32(acc, Qs + 32 * lt * 136, 136, Ks + 32 * st * 136, 136, 8, lane);
        const int s = 32 * st + r; const float as = fa[s], bs = fb[s];
#pragma unroll
        for (int i = 0; i < 16; ++i) { const int l = 32 * lt + crow(i, h);
            float sc = 0.f; if (s <= l) sc = __expf(fb[l] - bs + as - fmt[l]) * acc[i];
            const bf16 sb = f2bf(sc); Ps[l * 72 + s] = sb; const float rsum = red32_sum(bf2f(sb)); if (r == 0) frs[st * 64 + l] = rsum; }
    }
    __syncthreads();
    {
        const int lt = wave & 1, vt = wave >> 1; f32x16 ae, as_; for (int i = 0; i < 16; ++i) { ae[i] = 0.f; as_[i] = 0.f; }
        ae = mma32(ae, Qs + 32 * lt * 136, 136, Et + 32 * vt * 136, 136, 8, lane);
        as_ = mma32(as_, Ps + 32 * lt * 72, 72, VT + 32 * vt * 72, 72, 4, lane);
        float hv[16];
#pragma unroll
        for (int i = 0; i < 16; ++i) { const int l = 32 * lt + crow(i, h); const float wi = fwi[l]; const float den = wi * fqn[l] + frs[l] + frs[64 + l];
            const float dn = fmaxf(fabsf(den), __expf(-fmt[l])); hv[i] = (wi * ae[i] + as_[i]) / dn;
            const float sq = red32_sum(hv[i] * hv[i]); if (r == 0) fss[vt * 64 + l] = sq; }
        __syncthreads();
        const int v = 32 * vt + r; const float gv = a.ng[hh * 128 + v];
#pragma unroll
        for (int i = 0; i < 16; ++i) { const int l = 32 * lt + crow(i, h); const float ss = fss[l] + fss[64 + l] + fss[128 + l] + fss[192 + l];
            const float rstd = rsqrtf(ss * (1.0f / 128.0f) + EPS); const size_t prow = (size_t)(t0 + l) * NPROJ;
            const float om = bf2f(a.P[prow + C_OM + hh * 128 + v]); a.P[prow + C_QM + hh * 128 + v] = f2bf(hv[i] * rstd * gv * sigmoidf_(om)); }
    }
    __syncthreads();
}
struct AtArgs { bf16* P; const float* KSUM; };
__device__ __forceinline__ void attn_unit(const AtArgs& a, LAS unsigned char* lds, int tid, int bh, int j) {
    const int lane = tid & 63, wave = tid >> 6, r = lane & 31, h = lane >> 5;
    const int b = bh >> 3, hh = bh & 7, q0 = b * SEQ + j * 256;
    LAS float* kmean = (LAS float*)lds;
    LAS unsigned* qmask = (LAS unsigned*)(kmean + 1024);
    LAS unsigned* anym = qmask + 256;
    LAS bf16* Kb = (LAS bf16*)(anym + 8);
    constexpr int VST = 72;
    LAS bf16* Vb = Kb + 2 * 64 * 72;
    for (int e = tid; e < 1024; e += 512) { const int n = e >> 6, d = e & 63; const float* ks = a.KSUM + ((size_t)bh * 64 + n * 4) * 64 + d; kmean[e] = (ks[0] + ks[64] + ks[128] + ks[192]) * (1.0f / 256.0f); }
    __syncthreads();
    if (tid < 256) {
        unsigned msk = 0u;
        if (j > 0) {
            float qv[64]; const bf16* qp = a.P + (size_t)(q0 + tid) * NPROJ + C_QA + hh * 64;
#pragma unroll
            for (int k = 0; k < 8; ++k) { const u32x4 w = *(const u32x4*)(qp + 8 * k); f32x4 x0, x1; unpack8(w, x0, x1);
#pragma unroll
                for (int e = 0; e < 4; ++e) { qv[8 * k + e] = x0[e]; qv[8 * k + 4 + e] = x1[e]; } }
            float v0 = -3e38f, v1 = -3e38f, v2 = -3e38f; int i0 = -1, i1 = -1, i2 = -1;
            for (int n = 0; n < j; ++n) { float g = 0.f;
#pragma unroll
                for (int d = 0; d < 64; ++d) g += qv[d] * kmean[n * 64 + d];
                if (g > v0) { v2 = v1; i2 = i1; v1 = v0; i1 = i0; v0 = g; i0 = n; } else if (g > v1) { v2 = v1; i2 = i1; v1 = g; i1 = n; } else if (g > v2) { v2 = g; i2 = n; } }
            if (i0 >= 0) msk |= 1u << i0; if (i1 >= 0) msk |= 1u << i1; if (i2 >= 0) msk |= 1u << i2;
        }
        qmask[tid] = msk;
        unsigned om = msk;
#pragma unroll
        for (int o = 1; o < 64; o <<= 1) om |= __shfl_xor(om, o);
        if (lane == 0) anym[wave] = om;
    }
    __syncthreads();
    const unsigned blkmask = (anym[0] | anym[1] | anym[2] | anym[3]) | (1u << j);
    const unsigned mymask = qmask[32 * wave + r];
    bf16x8 bq[4];
    { const bf16* qp = a.P + (size_t)(q0 + 32 * wave + r) * NPROJ + C_QA + hh * 64 + 8 * h;
#pragma unroll
      for (int ks = 0; ks < 4; ++ks) bq[ks] = *(const bf16x8*)(qp + 16 * ks); }
    f32x16 o0, o1; for (int i = 0; i < 16; ++i) { o0[i] = 0.f; o1[i] = 0.f; }
    float mrun = NEGF, lrun = 0.f;
    const int srow = tid >> 3, sch = (tid & 7) * 8;
    const bf16* kbase = a.P + (size_t)(b * SEQ) * NPROJ + C_KA + hh * 64 + sch;
    const bf16* vbase = a.P + (size_t)(b * SEQ) * NPROJ + C_VA + hh * 64 + sch;
    unsigned rem = blkmask; int n = __builtin_ctz(rem), t = 0; rem &= rem - 1;
    u32x4 kreg = *(const u32x4*)(kbase + (size_t)(n * 256 + t * 64 + srow) * NPROJ), vreg = *(const u32x4*)(vbase + (size_t)(n * 256 + t * 64 + srow) * NPROJ);
    int buf = 0;
    for (;;) {
        LAS bf16* Kc = Kb + buf * 64 * 72; LAS bf16* Vc = Vb + buf * 64 * VST;
        *(LAS u32x4*)(Kc + srow * 72 + sch) = kreg;
        *(LAS u32x4*)(Vc + srow * VST + sch) = vreg;
        __syncthreads();
        const int cn = n, ct = t;
        bool more = true; if (t < 3) ++t; else if (rem) { n = __builtin_ctz(rem); rem &= rem - 1; t = 0; } else more = false;
        if (more) { kreg = *(const u32x4*)(kbase + (size_t)(n * 256 + t * 64 + srow) * NPROJ); vreg = *(const u32x4*)(vbase + (size_t)(n * 256 + t * 64 + srow) * NPROJ); }
        const bool own = (cn == j);
        const bool active = own ? (2 * ct <= wave) : true;
        if (active) {
            const bool sel = own ? true : (((mymask >> cn) & 1u) != 0u);
            const float sb = sel ? 0.f : NEGF;
            f32x16 s0, s1; for (int i = 0; i < 16; ++i) { s0[i] = sb; s1[i] = sb; }
            { const LAS bf16* kp0 = Kc + r * 72 + 8 * h; const LAS bf16* kp1 = kp0 + 32 * 72;
#pragma unroll
              for (int ks = 0; ks < 4; ++ks) { s0 = __builtin_amdgcn_mfma_f32_32x32x16_bf16(*(const LAS bf16x8*)(kp0 + 16 * ks), bq[ks], s0, 0, 0, 0);
                                               s1 = __builtin_amdgcn_mfma_f32_32x32x16_bf16(*(const LAS bf16x8*)(kp1 + 16 * ks), bq[ks], s1, 0, 0, 0); } }
            if (own) { const int qrel = 32 * wave + r - 64 * ct;
#pragma unroll
                for (int i = 0; i < 16; ++i) { const int kk = crow(i, h); if (kk > qrel) s0[i] = NEGF; if (kk + 32 > qrel) s1[i] = NEGF; } }
            float tm = fmaxf(s0[0], s1[0]);
#pragma unroll
            for (int i = 1; i < 16; ++i) tm = fmaxf(tm, fmaxf(s0[i], s1[i]));
            tm = fmaxf(tm, __shfl_xor(tm, 32));
            const float mnew = fmaxf(mrun, tm);
            const float alpha = __builtin_amdgcn_exp2f(mrun - mnew);
            float ps = 0.f;
#pragma unroll
            for (int i = 0; i < 16; ++i) { s0[i] = __builtin_amdgcn_exp2f(s0[i] - mnew); s1[i] = __builtin_amdgcn_exp2f(s1[i] - mnew); ps += s0[i] + s1[i]; }
            lrun = lrun * alpha + ps; mrun = mnew;
#pragma unroll
            for (int i = 0; i < 16; ++i) { o0[i] *= alpha; o1[i] *= alpha; }
#pragma unroll
            for (int kt = 0; kt < 2; ++kt)
#pragma unroll
                for (int ss = 0; ss < 2; ++ss) {
                    const f32x16& sx = kt ? s1 : s0; u32x4 pw; pw.x = cvtpk(sx[8 * ss], sx[8 * ss + 1]); pw.y = cvtpk(sx[8 * ss + 2], sx[8 * ss + 3]); pw.z = cvtpk(sx[8 * ss + 4], sx[8 * ss + 5]); pw.w = cvtpk(sx[8 * ss + 6], sx[8 * ss + 7]);
                    const bf16x8 pb = __builtin_bit_cast(bf16x8, pw);
                    const LAS bf16* vp = Vc + (32 * kt + 16 * ss + 4 * h + ((lane & 15) >> 2)) * VST + 16 * ((lane >> 4) & 1) + 4 * (lane & 3);
                    { const u32x2 lo = lds_tr(vp), hi = lds_tr(vp + 8 * VST); u32x4 va; va.x = lo.x; va.y = lo.y; va.z = hi.x; va.w = hi.y;
                      o0 = __builtin_amdgcn_mfma_f32_32x32x16_bf16(__builtin_bit_cast(bf16x8, va), pb, o0, 0, 0, 0); }
                    { const u32x2 lo = lds_tr(vp + 32), hi = lds_tr(vp + 8 * VST + 32); u32x4 va; va.x = lo.x; va.y = lo.y; va.z = hi.x; va.w = hi.y;
                      o1 = __builtin_amdgcn_mfma_f32_32x32x16_bf16(__builtin_bit_cast(bf16x8, va), pb, o1, 0, 0, 0); }
                }
        }
        if (!more) break;
        buf ^= 1;
    }
    lrun += __shfl_xor(lrun, 32);
    const float inv = 1.0f / lrun;
    __syncthreads();
    bf16* op = a.P + (size_t)(q0 + 32 * wave + r) * NPROJ + C_QA + hh * 64;
#pragma unroll
    for (int g = 0; g < 4; ++g) { u32x2 w0, w1; w0.x = cvt_pk_bf16(o0[4 * g] * inv, o0[4 * g + 1] * inv); w0.y = cvt_pk_bf16(o0[4 * g + 2] * inv, o0[4 * g + 3] * inv);
        w1.x = cvt_pk_bf16(o1[4 * g] * inv, o1[4 * g + 1] * inv); w1.y = cvt_pk_bf16(o1[4 * g + 2] * inv, o1[4 * g + 3] * inv);
        *(u32x2*)(op + 8 * g + 4 * h) = w0; *(u32x2*)(op + 32 + 8 * g + 4 * h) = w1; }
    __syncthreads();
}
__device__ __forceinline__ void p9_conv(const bf16* U, bf16* Gh, const float* cw, int tid, int G) {
    const int gt = blockIdx.x * 512 + tid, NT = G * 512;
    for (int it = gt; it < 1024 * 352; it += NT) { const int ch = it / 352, cg8 = (it % 352) * 8; const int r0 = ch * 8; const bool first = (r0 & (SEQ - 1)) == 0;
        u32x4 gr[10], ur[10];
#pragma unroll
        for (int k = 0; k < 10; ++k) { const bool ok = (k >= 2) || !first; const bf16* p = U + (size_t)(r0 - 2 + k) * NUP + cg8;
            gr[k] = ok ? *(const u32x4*)p : (u32x4){0u, 0u, 0u, 0u}; ur[k] = ok ? *(const u32x4*)(p + DFF) : (u32x4){0u, 0u, 0u, 0u}; }
        f32x4 wg[3][2], wu[3][2];
#pragma unroll
        for (int k = 0; k < 3; ++k) { wg[k][0] = *(const f32x4*)(cw + k * NUP + cg8); wg[k][1] = *(const f32x4*)(cw + k * NUP + cg8 + 4); wu[k][0] = *(const f32x4*)(cw + k * NUP + DFF + cg8); wu[k][1] = *(const f32x4*)(cw + k * NUP + DFF + cg8 + 4); }
        f32x4 g0[2], g1[2], u0[2], u1[2];
        unpack8(gr[0], g0[0], g0[1]); unpack8(gr[1], g1[0], g1[1]); unpack8(ur[0], u0[0], u0[1]); unpack8(ur[1], u1[0], u1[1]);
#pragma unroll
        for (int t = 0; t < 8; ++t) { f32x4 g2[2], u2[2]; unpack8(gr[t + 2], g2[0], g2[1]); unpack8(ur[t + 2], u2[0], u2[1]);
            f32x4 o[2];
#pragma unroll
            for (int e = 0; e < 2; ++e) { const f32x4 gg = wg[0][e] * g0[e] + wg[1][e] * g1[e] + wg[2][e] * g2[e]; const f32x4 uu = wu[0][e] * u0[e] + wu[1][e] * u1[e] + wu[2][e] * u2[e];
                o[e] = (f32x4){siluf_(gg[0]) * uu[0], siluf_(gg[1]) * uu[1], siluf_(gg[2]) * uu[2], siluf_(gg[3]) * uu[3]}; g0[e] = g1[e]; g1[e] = g2[e]; u0[e] = u1[e]; u1[e] = u2[e]; }
            *(u32x4*)(Gh + (size_t)(r0 + t) * DFF + cg8) = pack8(o[0], o[1]); }
    }
}
__device__ __forceinline__ void p11_final(float* out, const float* rss2, const float* gf, int tid, int G) {
    const int lane = tid & 63, wave = tid >> 6; const int gw = blockIdx.x * 8 + wave, NGW = G * 8;
    for (int m = gw; m < MT; m += NGW) { const float rstd = rsqrtf(rss2[m] * (1.0f / DM) + EPS); f32x4* xr = (f32x4*)(out + (size_t)m * DM) + lane;
#pragma unroll
        for (int jj = 0; jj < 4; ++jj) { const f32x4 g = *((const f32x4*)gf + lane + 64 * jj); xr[64 * jj] = xr[64 * jj] * rstd * g; } }
}

struct Args { const float* in[16]; float* out; unsigned char* ws; int use_cg; int pad; };
#define GSYNC() grid.sync()
#define XBAR() do { XcdBarrier xb_; xb_.bar = (unsigned*)KWS(WS_BAR); xb_.x = xb_xcc_id(); xb_.st = (volatile LAS unsigned*)(lds + 131072 + 512); xcd_barrier(xb_); } while (0)
#ifndef PROBE
#define PROBE 0
#endif
#ifndef PROBE_K
#define PROBE_K 1
#endif
#define PB(n) do { if (PROBE == (n)) pt0 = __builtin_amdgcn_s_memrealtime(); } while (0)
#define PE(n) do { if (PROBE == (n)) pdt += __builtin_amdgcn_s_memrealtime() - pt0; } while (0)
#define XB_TMO      128
#define XB_XCNT(j)  (256  + 64 * (j))
#define XB_XSUB(j)  (1280 + 64 * (j))
#define XB_XGEN(j)  (2304 + 64 * (j))
#define XB_TOP      3328
#define XB_TOPGEN   3392
#define XCD_BAR_WORDS 3456
#define XB_SPIN_CAP (1u << 18)

__device__ __forceinline__ unsigned xb_ld(unsigned* p)              { return __hip_atomic_load(p, __ATOMIC_RELAXED, __HIP_MEMORY_SCOPE_AGENT); }
__device__ __forceinline__ unsigned xb_add(unsigned* p, unsigned v) { return __hip_atomic_fetch_add(p, v, __ATOMIC_RELAXED, __HIP_MEMORY_SCOPE_AGENT); }
__device__ __forceinline__ unsigned xb_xcc_id() { return (unsigned)__builtin_amdgcn_s_getreg((3 << 11) | 20) & 0xFu; }
#define XB_SPIN(cond, bar) do { unsigned _sp = 0; while (cond) { __builtin_amdgcn_s_sleep(1); \
    if ((++_sp & 255u) == 0u) { if (xb_ld(&(bar)[XB_TMO])) break; if (_sp > XB_SPIN_CAP) { atomicAdd(&(bar)[XB_TMO], 1u); break; } } } } while (0)

struct XcdBarrier {
    unsigned* bar; unsigned x;
    volatile LAS unsigned* st;
};

__device__ __forceinline__ XcdBarrier xcd_barrier_post(unsigned* bar, volatile LAS unsigned* st) {
    XcdBarrier b; b.bar = bar; b.x = xb_xcc_id(); b.st = st;
    if (threadIdx.x == 0) (void)xb_add(&bar[XB_XCNT(b.x)], 1u);
    return b;
}
__device__ __forceinline__ void xcd_barrier_complete(unsigned* bar, unsigned x, unsigned& nloc, unsigned& nx) {
    const unsigned G = gridDim.x * gridDim.y * gridDim.z;
    unsigned sum, cnt, mine, sp = 0u;
    for (;;) {
        sum = 0u; cnt = 0u; mine = 0u;
#pragma unroll
        for (unsigned j = 0; j < 16; ++j) { const unsigned c = xb_ld(&bar[XB_XCNT(j)]); sum += c; cnt += (c > 0u) ? 1u : 0u; mine = (j == x) ? c : mine; }
        if (sum == G) break;
        __builtin_amdgcn_s_sleep(1);
        if ((++sp & 255u) == 0u) { if (xb_ld(&bar[XB_TMO])) break; if (sp > XB_SPIN_CAP) { atomicAdd(&bar[XB_TMO], 1u); break; } }
    }
    nloc = mine > 0u ? mine : 1u; nx = cnt > 0u ? cnt : 1u;
}

__device__ __forceinline__ void xcd_barrier(const XcdBarrier& b) {
    asm volatile("s_waitcnt vmcnt(0)" ::: "memory");
    __syncthreads();
    if (threadIdx.x == 0) {
        unsigned* bar = b.bar;
        __builtin_amdgcn_s_waitcnt(0);
        unsigned nloc = b.st[0], nx = b.st[1];
        if (nloc == 0u) { xcd_barrier_complete(bar, b.x, nloc, nx); b.st[0] = nloc; b.st[1] = nx; }
        const unsigned old = xb_add(&bar[XB_XSUB(b.x)], 1u);
        const unsigned gen = old / nloc;
        if (old + 1u == (gen + 1u) * nloc) {
            __builtin_amdgcn_fence(__ATOMIC_RELEASE, "agent");
            asm volatile("s_waitcnt vmcnt(0)" ::: "memory");
            const unsigned og = xb_add(&bar[XB_TOP], 1u);
            const unsigned tg = og / nx;
            if (og + 1u == (tg + 1u) * nx) xb_add(&bar[XB_TOPGEN], 1u);
            else XB_SPIN(xb_ld(&bar[XB_TOPGEN]) == tg, bar);
            __builtin_amdgcn_fence(__ATOMIC_ACQUIRE, "agent");
            xb_add(&bar[XB_XGEN(b.x)], 1u);
            asm volatile("s_waitcnt vmcnt(0)" ::: "memory");
        } else {
            XB_SPIN(xb_ld(&bar[XB_XGEN(b.x)]) == gen, bar);
            __builtin_amdgcn_fence(__ATOMIC_ACQUIRE, "agent");
            asm volatile("s_waitcnt vmcnt(0)" ::: "memory");
        }
    }
    __syncthreads();
}

__device__ __forceinline__ unsigned long long karg(int i) { const volatile unsigned long long* ka = (const volatile unsigned long long*)__builtin_amdgcn_kernarg_segment_ptr(); const unsigned long long v = ka[i]; const unsigned lo = __builtin_amdgcn_readfirstlane((unsigned)v), hi = __builtin_amdgcn_readfirstlane((unsigned)(v >> 32)); return ((unsigned long long)hi << 32) | lo; }
#define KIN(i) ((const float*)karg(i))
#define KOUT() ((float*)karg(16))
#define KWS(off) ((unsigned char*)karg(17) + (off))
__global__ void __launch_bounds__(512) fwd_mega(Args args) {
    extern __shared__ __attribute__((aligned(16))) unsigned char lds_raw[];
    cg::grid_group grid = cg::this_grid();
    LAS unsigned char* lds = (LAS unsigned char*)lds_raw;
    const int tid = threadIdx.x, G = gridDim.x;
    unsigned long long pt0 = 0, pdt = 0;
    if (tid < 2) ((volatile LAS unsigned*)(lds + 131072 + 512))[tid] = 0u;
    __syncthreads();
    (void)xcd_barrier_post((unsigned*)KWS(WS_BAR), (volatile LAS unsigned*)(lds + 131072 + 512));
    PB(1);
    { P0Args a{KIN(0), KIN(2), KIN(3), KIN(8), KIN(9), KIN(10), KIN(11), KIN(12), KIN(14), (bf16*)KWS(WS_WIN), (bf16*)KWS(WS_WBA), (bf16*)KWS(WS_WBM), (bf16*)KWS(WS_WO), (bf16*)KWS(WS_WUP), (bf16*)KWS(WS_WDN), (bf16*)KWS(WS_H), (float*)KWS(WS_RSS1), (float*)KWS(WS_RSS2)};
      p0_prologue(a, lds, tid, G); }
    if (__builtin_expect((int)karg(18) != 0, 0)) GSYNC(); else XBAR();
    PE(1);
    PB(2);
    { pg8::Gemm g{(const bf16*)KWS(WS_H), (const bf16*)KWS(WS_WIN), MT, NPROJ_PAD, DM, DM, DM, 1 << 30, 0}; pg8::StaticOrder S; S.init(MT, NPROJ_PAD, G, (int)blockIdx.x); EpiProj E{(bf16*)KWS(WS_PROJ)};
      pg8::gemm_phase<EpiProj, pg8::StaticOrder, true, true, DM, DM, DM>(lds, g, S, E); }
    XBAR();
    PE(2);
    PB(3);
    { P2Args a{(bf16*)KWS(WS_PROJ), (const int*)karg(1), KIN(4), KIN(5), KIN(6), (bf16*)KWS(WS_QM), (bf16*)KWS(WS_KM), (float*)KWS(WS_GA), (float*)KWS(WS_GB), (float*)KWS(WS_ST), (float*)KWS(WS_KSUM)};
      for (int u = blockIdx.x; u < 256; u += G) p2_unit(a, lds, tid, u); }
    XBAR();
    PE(3);
    PB(4);
    { P3Args a{(const bf16*)KWS(WS_PROJ), (const bf16*)KWS(WS_KM), (const float*)KWS(WS_GA), (const float*)KWS(WS_GB), (const float*)KWS(WS_ST), (bf16*)KOUT(), (float*)KWS(WS_NL), (float*)KWS(WS_MC), (float*)KWS(WS_CSC)};
      for (int u = blockIdx.x; u < 1024; u += G) p3_unit(a, lds, tid, u); }
    PE(4);
    PB(5);
    { AtArgs at{(bf16*)KWS(WS_PROJ), (const float*)KWS(WS_KSUM)};
      for (int p = blockIdx.x; p < 256; p += G) { const int bh = p >> 3, jj = p & 7; attn_unit(at, lds, tid, bh, jj); attn_unit(at, lds, tid, bh, 15 - jj); } }
    XBAR();
    PE(5);
    PB(6);
    p4_scan((bf16*)KOUT(), (float*)KWS(WS_NL), (const float*)KWS(WS_CSC), tid, G);
    XBAR();
    PE(6);
    PB(7);
    { P5Args a{(bf16*)KWS(WS_PROJ), (const bf16*)KWS(WS_QM), (const bf16*)KWS(WS_KM), (const float*)KWS(WS_GA), (const float*)KWS(WS_GB), (const bf16*)KOUT(), (const float*)KWS(WS_NL), (const float*)KWS(WS_MC), KIN(7)};
      for (int u = blockIdx.x; u < 1024; u += G) p5_unit(a, lds, tid, u); }
    XBAR();
    PE(7);
    PB(8);
    { pg8::Gemm g{(const bf16*)KWS(WS_PROJ) + C_QA, (const bf16*)KWS(WS_WBA), MT, 2 * DM, 512, NPROJ, 512, 4, C_QM - C_QA}; PairOrder S; S.init(G, (int)blockIdx.x); EpiGate2 E{(const bf16*)KWS(WS_PROJ), (bf16*)KWS(WS_MRG)};
      pg8::gemm_phase<EpiGate2, PairOrder, true, true, NPROJ, 512, 512>(lds, g, S, E); }
    XBAR();
    PE(8);
    PB(9);
    { pg8::Gemm g{(const bf16*)KWS(WS_MRG), (const bf16*)KWS(WS_WO), MT, DM, DM, DM, DM, 1 << 30, 0}; pg8::StaticOrder S; S.init(MT, DM, G, (int)blockIdx.x); EpiRes1 E{KIN(0), KOUT(), (bf16*)KWS(WS_X1B), (float*)KWS(WS_RSS1)};
      pg8::gemm_phase<EpiRes1, pg8::StaticOrder, true, true, DM, DM, DM>(lds, g, S, E); }
    XBAR();
    PE(9);
    for (int hf = 0; hf < 2; ++hf) {
        PB(10);
        { pg8::Gemm g{(const bf16*)KWS(WS_X1B) + (size_t)hf * 8192 * DM, (const bf16*)KWS(WS_WUP), 8192, NUP, DM, DM, DM, 1 << 30, 0}; pg8::StaticOrder S; S.init(8192, NUP, G, (int)blockIdx.x); EpiUp E{(bf16*)KWS(WS_U), (const float*)KWS(WS_RSS1) + hf * 8192};
          pg8::gemm_phase<EpiUp, pg8::StaticOrder, true, true, DM, DM, DM>(lds, g, S, E); }
        XBAR();
        PE(10);
        PB(11);
        p9_conv((const bf16*)KWS(WS_U), (bf16*)KWS(WS_G) + (size_t)hf * 8192 * DFF, KIN(13), tid, G);
        XBAR();
        PE(11);
    }
    PB(12);
    { pg8::Gemm g{(const bf16*)KWS(WS_G), (const bf16*)KWS(WS_WDN), MT, DM, DFF, DFF, DFF, 1 << 30, 0}; pg8::StaticOrder S; S.init(MT, DM, G, (int)blockIdx.x); EpiRes2 E{KOUT(), (float*)KWS(WS_RSS2)};
      pg8::gemm_phase<EpiRes2, pg8::StaticOrder, true, true, DFF, DFF, DFF>(lds, g, S, E); }
    XBAR();
    PE(12);
    PB(13);
    p11_final(KOUT(), (const float*)KWS(WS_RSS2), KIN(15), tid, G);
    PE(13);
    if (PROBE == 15) { PB(15); for (int k = 0; k < 8; ++k) XBAR(); PE(15); }
    if (PROBE != 0) { const unsigned long long te = __builtin_amdgcn_s_memrealtime(); while (__builtin_amdgcn_s_memrealtime() - te < pdt * PROBE_K) __builtin_amdgcn_s_sleep(8); }
}

extern "C" void kernel_launch(void* const* d_in, const int* in_sizes, int n_in, void* d_out, int out_size, void* d_ws, size_t ws_size, hipStream_t stream) {
    static int grid = 0;
    if (grid == 0) {
        if (n_in != 16 || out_size != MT * DM || ws_size < WS_END) { fprintf(stderr, "kernel_launch: unexpected shapes n_in %d out %d ws %zu\n", n_in, out_size, ws_size); grid = -1; return; }
        int dev = 0, cus = 0, per = 0;
        (void)hipGetDevice(&dev); (void)hipDeviceGetAttribute(&cus, hipDeviceAttributeMultiprocessorCount, dev);
        (void)hipFuncSetAttribute((const void*)fwd_mega, hipFuncAttributeMaxDynamicSharedMemorySize, LDS_BYTES);
        (void)hipOccupancyMaxActiveBlocksPerMultiprocessor(&per, (const void*)fwd_mega, 512, LDS_BYTES);
        if (per < 1) per = 1;
        grid = cus * per;
        fprintf(stderr, "kernel_launch: grid %d (cus %d x %d)\n", grid, cus, per);
    }
    if (grid < 0) return;
    if (hipMemsetAsync((char*)d_ws + WS_BAR, 0, XCD_BAR_WORDS * 4, stream) != hipSuccess) { fprintf(stderr, "kernel_launch: memset failed\n"); return; }
    Args a{};
    for (int i = 0; i < 16; ++i) a.in[i] = (const float*)d_in[i];
    a.out = (float*)d_out; a.ws = (unsigned char*)d_ws;
    void* kargs[] = {&a};
    hipError_t e = hipLaunchCooperativeKernel((const void*)fwd_mega, dim3(grid), dim3(512), kargs, LDS_BYTES, stream);
    if (e != hipSuccess) fprintf(stderr, "kernel_launch: cooperative launch failed: %s (grid %d)\n", hipGetErrorString(e), grid);
}
```
